# Optimizing an MI355X kernel written in HIP

```python
import math
import jax, jax.numpy as jnp
from jax import lax
import numpy as np

D_MODEL = 1024
BATCH = 2
SEQ = 8192
DEPTH = 2

HEAD_DIM = 64
MOBA_HEADS = 8
MOBA_WIDTH = MOBA_HEADS * HEAD_DIM
MOBA_BLOCK = 256
MOBA_TOPK = 3
MOBA_QCHUNK = 128
RWKV_HEADS = 8
RWKV_WIDTH = RWKV_HEADS * HEAD_DIM
DECAY_LORA = 64
ICLR_LORA = 64
GN_EPS = HEAD_DIM * 1e-5
DECAY_SCALE = math.exp(-0.5)
SWA_Q_HEADS = 8
SWA_KV_HEADS = 2
SWA_GROUP = SWA_Q_HEADS // SWA_KV_HEADS
SWA_WIDTH = SWA_Q_HEADS * HEAD_DIM
SWA_KV_WIDTH = SWA_KV_HEADS * HEAD_DIM
WINDOW = 128
SWA_BLOCK = 128
ROPE_THETA = 10000.0
LN_EPS = 1e-5
ALPHA = (2 * DEPTH) ** 0.25
BETA = (8 * DEPTH) ** -0.25

A_SPLITS = (MOBA_WIDTH, MOBA_WIDTH, MOBA_WIDTH, MOBA_WIDTH)
B_SPLITS = (RWKV_WIDTH, RWKV_WIDTH, RWKV_WIDTH, DECAY_LORA, ICLR_LORA, RWKV_WIDTH)
C_SPLITS = (SWA_WIDTH, SWA_KV_WIDTH, SWA_KV_WIDTH, SWA_WIDTH)
G_SPLITS = (D_MODEL, D_MODEL, D_MODEL)
GROUP_SPLITS = (sum(A_SPLITS), sum(B_SPLITS), sum(C_SPLITS), sum(G_SPLITS))
IN_WIDTH = sum(GROUP_SPLITS)
RWKV_IN_WIDTH = sum(B_SPLITS)

kernel_name = 'hybrid_moba_rwkv7_swa_sink_gated'


def _split(h, sizes):
    offs = np.cumsum(sizes)[:-1].tolist()
    return jnp.split(h, offs, axis=-1)


def layer_norm(x, g, b):
    xf = x.astype(jnp.float32)
    mu = xf.mean(-1, keepdims=True)
    var = jnp.square(xf - mu).mean(-1, keepdims=True)
    return ((xf - mu) * lax.rsqrt(var + LN_EPS) * g.astype(jnp.float32) + b.astype(jnp.float32)).astype(x.dtype)


def rope(x, positions):
    half = HEAD_DIM // 2
    inv = jnp.power(ROPE_THETA, -jnp.arange(half, dtype=jnp.float32) / half)
    ang = positions.astype(jnp.float32)[..., None] * inv
    cos = jnp.cos(ang)[:, :, None, :]
    sin = jnp.sin(ang)[:, :, None, :]
    xf = x.astype(jnp.float32)
    x1, x2 = xf[..., :half], xf[..., half:]
    return jnp.concatenate([x1 * cos - x2 * sin, x2 * cos + x1 * sin], axis=-1).astype(x.dtype)


def moba_attention(q, k, v):
    B, S, H, D = q.shape
    s_pad = -(-S // MOBA_BLOCK) * MOBA_BLOCK
    nb = s_pad // MOBA_BLOCK
    topk = min(MOBA_TOPK, nb)
    pad = ((0, 0), (0, s_pad - S), (0, 0), (0, 0))
    kb = jnp.pad(k, pad).reshape(B, nb, MOBA_BLOCK, H, D).transpose(0, 3, 1, 2, 4)
    vb = jnp.pad(v, pad).reshape(B, nb, MOBA_BLOCK, H, D).transpose(0, 3, 1, 2, 4)
    kmean = kb.astype(jnp.float32).mean(axis=3)
    qh = q.transpose(0, 2, 1, 3)
    bi = jnp.arange(B)[:, None, None, None]
    hi = jnp.arange(H)[None, :, None, None]
    blk_ids = jnp.arange(nb)
    offs = jnp.arange(MOBA_BLOCK)
    scale = D ** -0.5

    def chunk(c):
        q0 = c * MOBA_QCHUNK
        qc = lax.dynamic_slice_in_dim(qh, q0, MOBA_QCHUNK, axis=2)
        qpos = q0 + jnp.arange(MOBA_QCHUNK)
        own = q0 // MOBA_BLOCK
        gate = jnp.einsum('bhqd,bhnd->bhqn', qc.astype(jnp.float32), kmean)
        gate = jnp.where(blk_ids < own, gate, -jnp.inf)
        _, idx = lax.top_k(gate, topk)
        valid = idx < own
        ksel = kb[bi, hi, idx]
        vsel = vb[bi, hi, idx]
        s_sel = jnp.einsum('bhqd,bhqnkd->bhqnk', qc, ksel).astype(jnp.float32) * scale
        s_sel = jnp.where(valid[..., None], s_sel, -jnp.inf).reshape(B, H, MOBA_QCHUNK, topk * MOBA_BLOCK)
        kown = lax.dynamic_index_in_dim(kb, own, axis=2, keepdims=False)
        vown = lax.dynamic_index_in_dim(vb, own, axis=2, keepdims=False)
        s_own = jnp.einsum('bhqd,bhkd->bhqk', qc, kown).astype(jnp.float32) * scale
        kpos = own * MOBA_BLOCK + offs
        s_own = jnp.where(kpos[None, :] <= qpos[:, None], s_own, -jnp.inf)
        p = jax.nn.softmax(jnp.concatenate([s_sel, s_own], axis=-1), axis=-1).astype(v.dtype)
        p_sel = p[..., :topk * MOBA_BLOCK].reshape(B, H, MOBA_QCHUNK, topk, MOBA_BLOCK)
        p_own = p[..., topk * MOBA_BLOCK:]
        return (jnp.einsum('bhqnk,bhqnkd->bhqd', p_sel, vsel)
                + jnp.einsum('bhqk,bhkd->bhqd', p_own, vown))

    out = lax.map(chunk, jnp.arange(S // MOBA_QCHUNK))
    return out.transpose(1, 0, 3, 2, 4).reshape(B, S, H * D)


def swa_sink_attention(q, k, v, sinks):
    B, S, _, D = q.shape
    nb = S // SWA_BLOCK
    qb = q.reshape(B, nb, SWA_BLOCK, SWA_KV_HEADS, SWA_GROUP, D)
    pad = ((0, 0), (SWA_BLOCK, 0), (0, 0), (0, 0))
    kp = jnp.pad(k, pad).reshape(B, nb + 1, SWA_BLOCK, SWA_KV_HEADS, D)
    vp = jnp.pad(v, pad).reshape(B, nb + 1, SWA_BLOCK, SWA_KV_HEADS, D)
    kband = jnp.concatenate([kp[:, :-1], kp[:, 1:]], axis=2)
    vband = jnp.concatenate([vp[:, :-1], vp[:, 1:]], axis=2)
    s = jnp.einsum('bnqhgd,bnkhd->bnhgqk', qb, kband).astype(jnp.float32) * (D ** -0.5)
    qi = jnp.arange(SWA_BLOCK)[:, None]
    ki = jnp.arange(2 * SWA_BLOCK)[None, :] - SWA_BLOCK
    rel = qi - ki
    kabs = jnp.arange(nb)[:, None, None] * SWA_BLOCK + ki[None]
    mask = (rel >= 0)[None] & (rel < WINDOW)[None] & (kabs >= 0)
    s = jnp.where(mask[None, :, None, None], s, -jnp.inf)
    sink = sinks.astype(jnp.float32).reshape(SWA_KV_HEADS, SWA_GROUP)[None, None, :, :, None, None]
    m = jnp.maximum(s.max(-1, keepdims=True), sink)
    p = jnp.exp(s - m)
    denom = p.sum(-1, keepdims=True) + jnp.exp(sink - m)
    o = jnp.einsum('bnhgqk,bnkhd->bnqhgd', (p / denom).astype(v.dtype), vband)
    return o.reshape(B, S, SWA_Q_HEADS * D)


def rwkv7_time_mix(r, k, v, w_lo, a_lo, w0, w_up, a0, a_up, k_k, k_a, r_k, gn_g, gn_b):
    B, S, _ = r.shape
    H, D = RWKV_HEADS, HEAD_DIM
    f = lambda t: t.astype(jnp.float32)
    r, k, v, w_lo, a_lo = f(r), f(k), f(v), f(w_lo), f(a_lo)
    decay = jnp.exp(-DECAY_SCALE * jax.nn.sigmoid(f(w0) + jnp.tanh(w_lo) @ f(w_up)))
    a = jax.nn.sigmoid(f(a0) + a_lo @ f(a_up))
    kk = (k * f(k_k)).reshape(B, S, H, D)
    kk = kk / jnp.maximum(jnp.sqrt(jnp.sum(kk * kk, -1, keepdims=True)), 1e-12)
    k = k * (1.0 + (a - 1.0) * f(k_a))
    hd = lambda t: t.reshape(B, S, H, D)
    r4, k4, v4, w4, a4 = hd(r), hd(k), hd(v), hd(decay), hd(a)
    xs = tuple(jnp.moveaxis(t, 1, 0) for t in (r4, w4, k4, v4, kk, a4))

    def step(state, inp):
        r_t, w_t, k_t, v_t, kk_t, a_t = inp
        sa = jnp.einsum('bhvk,bhk->bhv', state, -kk_t)
        state = (state * w_t[:, :, None, :]
                 + sa[..., None] * (kk_t * a_t)[:, :, None, :]
                 + v_t[..., None] * k_t[:, :, None, :])
        return state, jnp.einsum('bhvk,bhk->bhv', state, r_t)

    state0 = jnp.zeros((B, H, D, D), jnp.float32)
    _, y = lax.scan(step, state0, xs)
    y = jnp.moveaxis(y, 0, 1)
    mu = y.mean(-1, keepdims=True)
    var = jnp.square(y - mu).mean(-1, keepdims=True)
    y = ((y - mu) * lax.rsqrt(var + GN_EPS)).reshape(B, S, H * D) * f(gn_g) + f(gn_b)
    bonus = (jnp.sum(r4 * k4 * f(r_k), -1, keepdims=True) * v4).reshape(B, S, H * D)
    return y + bonus


def hybrid_layer(x, positions, w_in, mu_rwkv, w0, w_up, a0, a_up, k_k, k_a, r_k,
                 gn_g, gn_b, sinks, w_branch_a, w_branch_b, w_branch_c, w_out, ln_g, ln_b):
    B, S, _ = x.shape
    h = x @ w_in
    hA, hB, hC, hG = _split(h, GROUP_SPLITS)
    qa, ka, va, za = _split(hA, A_SPLITS)
    qa = rope(qa.reshape(B, S, MOBA_HEADS, HEAD_DIM), positions)
    ka = rope(ka.reshape(B, S, MOBA_HEADS, HEAD_DIM), positions)
    oa = moba_attention(qa, ka, va.reshape(B, S, MOBA_HEADS, HEAD_DIM))
    hB_prev = jnp.pad(hB, ((0, 0), (1, 0), (0, 0)))[:, :S]
    hB = hB + (hB_prev - hB) * mu_rwkv
    rb, kb, vb, wlo, alo, zb = _split(hB, B_SPLITS)
    ob = rwkv7_time_mix(rb, kb, vb, wlo, alo, w0, w_up, a0, a_up, k_k, k_a, r_k, gn_g, gn_b).astype(x.dtype)
    qc, kc, vc, zc = _split(hC, C_SPLITS)
    qc = rope(qc.reshape(B, S, SWA_Q_HEADS, HEAD_DIM), positions)
    kc = rope(kc.reshape(B, S, SWA_KV_HEADS, HEAD_DIM), positions)
    oc = swa_sink_attention(qc, kc, vc.reshape(B, S, SWA_KV_HEADS, HEAD_DIM), sinks)
    ga, gb, gc = _split(hG, G_SPLITS)
    ya = (oa * jax.nn.silu(za)) @ w_branch_a
    yb = (ob * jax.nn.silu(zb)) @ w_branch_b
    yc = (oc * jax.nn.silu(zc)) @ w_branch_c
    merged = jax.nn.sigmoid(ga) * ya + jax.nn.sigmoid(gb) * yb + jax.nn.sigmoid(gc) * yc
    out = merged @ w_out
    return layer_norm(ALPHA * x + out, ln_g, ln_b)


def setup_inputs(seed: int = 0) -> dict:
    key = jax.random.key(seed)
    ks = jax.random.split(key, 24)
    L = DEPTH
    nrm = lambda k, shape, s: jax.random.normal(k, shape, jnp.float32) * s
    x = jax.random.normal(ks[0], (BATCH, SEQ, D_MODEL), jnp.float32)
    positions = jnp.broadcast_to(jnp.arange(SEQ, dtype=jnp.int32)[None, :], (BATCH, SEQ))
    return {
        'x': x,
        'positions': positions,
        'w_in': nrm(ks[1], (L, D_MODEL, IN_WIDTH), D_MODEL ** -0.5),
        'mu_rwkv': jax.random.uniform(ks[2], (L, RWKV_IN_WIDTH), jnp.float32),
        'w0': nrm(ks[3], (L, RWKV_WIDTH), 1.0),
        'w_up': nrm(ks[4], (L, DECAY_LORA, RWKV_WIDTH), 0.5 * DECAY_LORA ** -0.5),
        'a0': nrm(ks[5], (L, RWKV_WIDTH), 0.5),
        'a_up': nrm(ks[6], (L, ICLR_LORA, RWKV_WIDTH), 0.5 * ICLR_LORA ** -0.5),
        'k_k': 0.85 + nrm(ks[7], (L, RWKV_WIDTH), 0.05),
        'k_a': 1.0 + nrm(ks[8], (L, RWKV_WIDTH), 0.05),
        'r_k': nrm(ks[9], (L, RWKV_HEADS, HEAD_DIM), 0.1),
        'gn_g': 1.0 + nrm(ks[10], (L, RWKV_WIDTH), 0.05),
        'gn_b': nrm(ks[11], (L, RWKV_WIDTH), 0.01),
        'sinks': nrm(ks[12], (L, SWA_Q_HEADS), 1.0),
        'w_branch_a': nrm(ks[13], (L, MOBA_WIDTH, D_MODEL), BETA * MOBA_WIDTH ** -0.5),
        'w_branch_b': nrm(ks[14], (L, RWKV_WIDTH, D_MODEL), BETA * RWKV_WIDTH ** -0.5),
        'w_branch_c': nrm(ks[15], (L, SWA_WIDTH, D_MODEL), BETA * SWA_WIDTH ** -0.5),
        'w_out': nrm(ks[16], (L, D_MODEL, D_MODEL), BETA * D_MODEL ** -0.5),
        'ln_g': 1.0 + nrm(ks[17], (L, D_MODEL), 0.05),
        'ln_b': nrm(ks[18], (L, D_MODEL), 0.01),
    }


def reference(x, positions, w_in, mu_rwkv, w0, w_up, a0, a_up, k_k, k_a, r_k,
              gn_g, gn_b, sinks, w_branch_a, w_branch_b, w_branch_c, w_out, ln_g, ln_b):
    for l in range(DEPTH):
        x = hybrid_layer(x, positions, w_in[l], mu_rwkv[l], w0[l], w_up[l], a0[l], a_up[l],
                         k_k[l], k_a[l], r_k[l], gn_g[l], gn_b[l], sinks[l],
                         w_branch_a[l], w_branch_b[l], w_branch_c[l], w_out[l], ln_g[l], ln_b[l])
    return x
```

```cpp
#include <hip/hip_runtime.h>
#include <hip/hip_cooperative_groups.h>
#include <cstdio>
#include <cstdint>
namespace cg = cooperative_groups;
__device__ __forceinline__ int tid_l() { int t = threadIdx.x; asm volatile("" : "+v"(t)); return t; }
namespace pg8 {
#define PG8_LAS __attribute__((address_space(3)))
typedef unsigned short bf16_t;
typedef short bf16x8 __attribute__((ext_vector_type(8)));
typedef float f32x4 __attribute__((ext_vector_type(4)));
typedef unsigned u32x4 __attribute__((ext_vector_type(4)));
constexpr int BM = 256, BK = 64, HALF = 128, HTB = HALF * BK * 2  , STAGE_BYTES = 8 * HTB, NXCD = 8, WGM = 8;

__host__ __device__ __forceinline__ int lds_byte(int r, int c) { const int st = (r >> 4) * 2 + (c >> 5), rr = r & 15, cc = c & 31, ob = rr * 64 + cc * 2; return st * 1024 + (ob ^ (((ob >> 9) & 1) << 5)); }
__host__ __device__ __forceinline__ void stage_rc(int b, int& R, int& C) { const int st = b / 1024, sb = b % 1024, swz = sb ^ (((sb >> 9) & 1) << 5); R = (st >> 1) * 16 + swz / 64; C = (st & 1) * 32 + (swz % 64) / 2; }
__host__ __device__ __forceinline__ int perm32(int rho) { const int n = rho >> 4, i = rho & 15; return 8 * (i >> 2) + 4 * n + (i & 3); }

struct Unit { int pm, pn; };
struct Gemm { const bf16_t* A; const bf16_t* Bt; int M, N, K; };

struct StaticOrder {
    int nM, nN, nwg, G, c;
    __host__ __device__ void init(int M, int N, int G_, int c_) { nM = M / BM; nN = N / BM; nwg = nM * nN; G = G_; c = c_; }
    __host__ __device__ bool next(int i, Unit& u) const {
        const long L = (long)i * G + c; if (L >= nwg) return false;
        int wgid = (int)L; { const int q = nwg / NXCD, r = nwg % NXCD, xcd = wgid % NXCD, off = wgid / NXCD; wgid = (xcd < r ? xcd * (q + 1) : r * (q + 1) + (xcd - r) * q) + off; }
        const int nig = WGM * nN, gid = wgid / nig, fm = gid * WGM, gsz = (nM - fm) < WGM ? (nM - fm) : WGM;
        u.pm = fm + ((wgid % nig) % gsz); u.pn = (wgid % nig) / gsz; return true;
    }
    __device__ __forceinline__ void a_ready(const Unit&) const {}
    __device__ __forceinline__ void done(const Unit&) const {}
};

__device__ __forceinline__ unsigned cvt_pk_bf16(float lo, float hi) { unsigned r; asm volatile("v_cvt_pk_bf16_f32 %0, %1, %2" : "=v"(r) : "v"(lo), "v"(hi)); return r; }
template <class Epi, class Sched, bool ALIGN_EPI = false, bool SP2 = false>
__device__ __forceinline__ void gemm_phase(PG8_LAS unsigned char* lds, const Gemm g, const Sched& S, const Epi& E) {
    const int tid = tid_l(), wid = __builtin_amdgcn_readfirstlane(tid >> 6), lane = tid & 63, wr = wid >> 2, wc = wid & 3, fr = lane & 15, fq = lane >> 4;
    const int K = g.K, nt = K / BK;
    unsigned voffA[2], voffB[2];
#pragma unroll
    for (int i = 0; i < 2; ++i) { int R, C; stage_rc(tid * 16 + i * 8192, R, C); const int Rb = Epi::PERM ? ((R & ~31) + perm32(R & 31)) : R;
        voffA[i] = (unsigned)(R * K + C) * 2u; voffB[i] = (unsigned)(Rb * K + C) * 2u; }
    const size_t kstep = (size_t)(BK * 2);
    const size_t hstep = (size_t)HALF * K * 2;
    const size_t tstep = 2 * hstep;
    const unsigned ldsw = (unsigned)wid * 1024u;
    const int aoff = lds_byte(wr * 64 + fr, fq * 8), boff = lds_byte(wc * 32 + fr, fq * 8);
#define PG8_SA(b, h) (((b) * 2 + (h)) * HTB)
#define PG8_SB(b, h) ((4 + (b) * 2 + (h)) * HTB)
#define PG8_STAGE(bufoff, gbase, voff) do { _Pragma("unroll") for (int _i = 0; _i < 2; ++_i) \
        __builtin_amdgcn_global_load_lds((const unsigned*)((const char*)(gbase) + (voff)[_i]), (PG8_LAS unsigned*)(lds + (bufoff) + ldsw + _i * 8192), 16, 0, 0); } while (0)
#define PG8_LDA(dst, b, h) do { _Pragma("unroll") for (int m = 0; m < 4; ++m) _Pragma("unroll") for (int k = 0; k < 2; ++k) dst[m][k] = *(const PG8_LAS bf16x8*)(lds + PG8_SA(b, h) + aoff + m * 2048 + k * 1024); } while (0)
#define PG8_LDB(dst, b, h) do { _Pragma("unroll") for (int n = 0; n < 2; ++n) _Pragma("unroll") for (int k = 0; k < 2; ++k) dst[n][k] = *(const PG8_LAS bf16x8*)(lds + PG8_SB(b, h) + boff + n * 2048 + k * 1024); } while (0)
#define PG8_MMA(ai, bj, At, Bt) do { __builtin_amdgcn_s_setprio(1); _Pragma("unroll") for (int m = 0; m < 4; ++m) _Pragma("unroll") for (int n = 0; n < 2; ++n) _Pragma("unroll") for (int k = 0; k < 2; ++k) \
        acc[ai][bj][m][n] = __builtin_amdgcn_mfma_f32_16x16x32_bf16(Bt[n][k], At[m][k], acc[ai][bj][m][n], 0, 0, 0); __builtin_amdgcn_s_setprio(0); } while (0)
#define PG8_WAIT_V(n) asm volatile("s_waitcnt vmcnt(" #n ")" ::: "memory")
#define PG8_WAIT_L(n) asm volatile("s_waitcnt lgkmcnt(" #n ")" ::: "memory")
#define PG8_BAR __builtin_amdgcn_s_barrier()
#define PG8_SCHED __builtin_amdgcn_sched_barrier(0)
    Unit cur, nxt; int ui = 0;
    if (!S.next(0, cur)) return;
    f32x4 acc[2][2][4][2];
#pragma unroll
    for (int a = 0; a < 2; ++a)
#pragma unroll
        for (int b = 0; b < 2; ++b)
#pragma unroll
            for (int m = 0; m < 4; ++m)
#pragma unroll
                for (int n = 0; n < 2; ++n) acc[a][b][m][n] = (f32x4){0.f, 0.f, 0.f, 0.f};
    bf16x8 At[4][2], B0[2][2], B1[2][2];
    const char* cA = (const char*)g.A + (size_t)cur.pm * tstep; const char* cB = (const char*)g.Bt + (size_t)cur.pn * tstep;
    S.a_ready(cur);
    if constexpr (SP2) {
        PG8_STAGE(PG8_SB(0, 0), cB, voffB); PG8_STAGE(PG8_SB(0, 1), cB + hstep, voffB); PG8_STAGE(PG8_SA(0, 0), cA, voffA); PG8_STAGE(PG8_SA(0, 1), cA + hstep, voffA);
        if (wr == 1) PG8_BAR;
        PG8_WAIT_V(2); PG8_BAR;
        PG8_STAGE(PG8_SB(1, 0), cB + kstep, voffB); PG8_STAGE(PG8_SA(1, 0), cA + kstep, voffA); PG8_STAGE(PG8_SB(1, 1), cB + hstep + kstep, voffB);
        PG8_WAIT_V(6); PG8_BAR;
    } else {
        PG8_STAGE(PG8_SB(0, 0), cB, voffB); PG8_STAGE(PG8_SA(0, 0), cA, voffA); PG8_STAGE(PG8_SB(0, 1), cB + hstep, voffB); PG8_STAGE(PG8_SA(0, 1), cA + hstep, voffA);
        if (wr == 1) PG8_BAR;
        PG8_WAIT_V(4); PG8_BAR;
        PG8_STAGE(PG8_SB(1, 0), cB + kstep, voffB); PG8_STAGE(PG8_SA(1, 0), cA + kstep, voffA); PG8_STAGE(PG8_SB(1, 1), cB + hstep + kstep, voffB);
        PG8_WAIT_V(6); PG8_BAR;
    }
    for (;;) {
        const bool has_next = S.next(ui + 1, nxt);
        const char* nA = has_next ? (const char*)g.A + (size_t)nxt.pm * tstep : cA; const char* nB = has_next ? (const char*)g.Bt + (size_t)nxt.pn * tstep : cB;
        for (int t = 0; t < nt; t += 2) {
            const bool last = (t == nt - 2);
            const char* a1 = cA + (size_t)(t + 1) * kstep;
            const char* a2 = last ? nA : cA + (size_t)(t + 2) * kstep; const char* b2 = last ? nB : cB + (size_t)(t + 2) * kstep;
            const char* a3 = a2 + kstep; const char* b3 = b2 + kstep;
            if (last && has_next) S.a_ready(nxt);
            if constexpr (SP2) {
            PG8_LDB(B0, 0, 0); PG8_LDB(B1, 0, 1); PG8_SCHED; PG8_LDA(At, 0, 0); PG8_STAGE(PG8_SA(1, 1), a1 + hstep, voffA);
            PG8_WAIT_V(8); PG8_WAIT_L(0); PG8_BAR; PG8_MMA(0, 0, At, B0); PG8_MMA(0, 1, At, B1); PG8_BAR; PG8_SCHED;
            PG8_LDA(At, 0, 1); PG8_STAGE(PG8_SB(0, 0), b2, voffB); PG8_STAGE(PG8_SB(0, 1), b2 + hstep, voffB); PG8_STAGE(PG8_SA(0, 0), a2, voffA);
            PG8_WAIT_V(8); PG8_WAIT_L(0); PG8_BAR; PG8_MMA(1, 0, At, B0); PG8_MMA(1, 1, At, B1); PG8_BAR; PG8_SCHED;
            PG8_LDB(B0, 1, 0); PG8_LDB(B1, 1, 1); PG8_SCHED; PG8_LDA(At, 1, 0); PG8_STAGE(PG8_SA(0, 1), a2 + hstep, voffA);
            PG8_WAIT_V(8); PG8_WAIT_L(0); PG8_BAR; PG8_MMA(0, 0, At, B0); PG8_MMA(0, 1, At, B1); PG8_BAR; PG8_SCHED;
            PG8_LDA(At, 1, 1); PG8_STAGE(PG8_SB(1, 0), b3, voffB); PG8_STAGE(PG8_SB(1, 1), b3 + hstep, voffB); PG8_STAGE(PG8_SA(1, 0), a3, voffA);
            PG8_WAIT_V(8); PG8_WAIT_L(0); PG8_BAR; PG8_MMA(1, 0, At, B0); PG8_MMA(1, 1, At, B1); PG8_BAR; PG8_SCHED;
            } else {
            PG8_LDB(B0, 0, 0); PG8_SCHED; PG8_LDA(At, 0, 0); PG8_STAGE(PG8_SA(1, 1), a1 + hstep, voffA);
            PG8_WAIT_L(8); PG8_BAR; PG8_WAIT_L(0); PG8_MMA(0, 0, At, B0); PG8_BAR; PG8_SCHED;
            PG8_LDB(B1, 0, 1); PG8_STAGE(PG8_SB(0, 0), b2, voffB);
            PG8_BAR; PG8_WAIT_L(0); PG8_MMA(0, 1, At, B1); PG8_BAR;
            PG8_LDA(At, 0, 1); PG8_STAGE(PG8_SA(0, 0), a2, voffA);
            PG8_BAR; PG8_WAIT_L(0); PG8_MMA(1, 0, At, B0); PG8_BAR; PG8_SCHED;
            PG8_STAGE(PG8_SB(0, 1), b2 + hstep, voffB);
            PG8_WAIT_V(6); PG8_BAR; PG8_MMA(1, 1, At, B1); PG8_BAR;
            PG8_LDB(B0, 1, 0); PG8_SCHED; PG8_LDA(At, 1, 0); PG8_STAGE(PG8_SA(0, 1), a2 + hstep, voffA);
            PG8_WAIT_L(8); PG8_BAR; PG8_WAIT_L(0); PG8_MMA(0, 0, At, B0); PG8_BAR; PG8_SCHED;
            PG8_LDB(B1, 1, 1); PG8_STAGE(PG8_SB(1, 0), b3, voffB);
            PG8_BAR; PG8_WAIT_L(0); PG8_MMA(0, 1, At, B1); PG8_BAR;
            PG8_LDA(At, 1, 1); PG8_STAGE(PG8_SA(1, 0), a3, voffA);
            PG8_BAR; PG8_WAIT_L(0); PG8_MMA(1, 0, At, B0); PG8_BAR; PG8_SCHED;
            PG8_STAGE(PG8_SB(1, 1), b3 + hstep, voffB);
            PG8_WAIT_V(6); PG8_BAR; PG8_MMA(1, 1, At, B1); PG8_BAR;
            }
        }
        if constexpr (ALIGN_EPI) { if (wr == 0) PG8_BAR; }
        if constexpr (!Epi::AFTER_DRAIN) { E(acc, cur, wr, wc, fr, fq); S.done(cur); }
        if (!has_next) break;
#pragma unroll
        for (int a = 0; a < 2; ++a)
#pragma unroll
            for (int b = 0; b < 2; ++b)
#pragma unroll
                for (int m = 0; m < 4; ++m)
#pragma unroll
                    for (int n = 0; n < 2; ++n) acc[a][b][m][n] = (f32x4){0.f, 0.f, 0.f, 0.f};
        cur = nxt; cA = nA; cB = nB; ++ui;
        if constexpr (ALIGN_EPI) { if (wr == 1) PG8_BAR; }
    }
    PG8_WAIT_V(0);
    if constexpr (!ALIGN_EPI) { if (wr == 0) PG8_BAR; }
    PG8_BAR;
    if constexpr (Epi::AFTER_DRAIN) { E.fused(acc, cur, wr, wc, fr, fq, lds, wid, lane); S.done(cur); }
#undef PG8_SA
#undef PG8_SB
#undef PG8_STAGE
#undef PG8_LDA
#undef PG8_LDB
#undef PG8_MMA
#undef PG8_WAIT_V
#undef PG8_WAIT_L
#undef PG8_BAR
#undef PG8_SCHED
}
}

#define LAS __attribute__((address_space(3)))
using pg8::bf16_t; using pg8::bf16x8; using pg8::f32x4; using pg8::Unit;
typedef float f32x16 __attribute__((ext_vector_type(16)));
typedef unsigned u32x4 __attribute__((ext_vector_type(4)));
typedef unsigned u32x2 __attribute__((ext_vector_type(2)));

constexpr int MTOK = 16384, SEQL = 8192, DM = 1024, INW = 8576, NLAYER = 2;
constexpr float C2F = 0.125f * 1.4426950408889634f;
constexpr float LOG2E = 1.4426950408889634f;
constexpr float NEGF = -1.0e30f;
constexpr float ALPHA_RES = 1.4142135623730951f;
constexpr int NTHR = 512;
#ifndef PHMASK
#define PHMASK 0x1ff
#endif
constexpr int LDS_BYTES = 147456;

constexpr size_t MiB = 1u << 20;
constexpr size_t WS_CTL = 0;
constexpr size_t WS_COS = 1 * MiB;
constexpr size_t WS_SIN = 3 * MiB;
constexpr size_t WS_KMEAN = 5 * MiB;
constexpr size_t WS_RK = 5 * MiB + 256 * 1024;
constexpr size_t WS_BND = 6 * MiB;
constexpr size_t WS_XB = 7 * MiB;
constexpr size_t WS_WIN = 39 * MiB;
constexpr size_t WS_WBR = 56 * MiB;
constexpr size_t WS_WOUT = 59 * MiB;
constexpr size_t WS_QA = 61 * MiB;
constexpr size_t WS_KA = 77 * MiB;
constexpr size_t WS_VA = 93 * MiB;
constexpr size_t WS_RB = 109 * MiB;
constexpr size_t WS_KB = 125 * MiB;
constexpr size_t WS_VB = 141 * MiB;
constexpr size_t WS_MISC = 157 * MiB;
constexpr size_t WS_OB = 173 * MiB;
constexpr size_t WS_QC = 189 * MiB;
constexpr size_t WS_DW = 205 * MiB;
constexpr size_t WS_KK = 221 * MiB;
constexpr size_t WS_BB = 237 * MiB;
constexpr size_t WS_END = 253 * MiB;
constexpr size_t WS_Y = WS_KA;
constexpr size_t WS_MERGED = WS_RB;

__device__ __forceinline__ float bflo(unsigned u) { return __uint_as_float(u << 16); }
__device__ __forceinline__ float bfhi(unsigned u) { return __uint_as_float(u & 0xffff0000u); }
__device__ __forceinline__ unsigned pk2(float lo, float hi) { return pg8::cvt_pk_bf16(lo, hi); }
__device__ __forceinline__ float sigmoidf_(float x) { return 1.0f / (1.0f + __expf(-x)); }
__device__ __forceinline__ int crow(int r, int hi) { return (r & 3) + 8 * (r >> 2) + 4 * hi; }
#define LDS_WAIT() asm volatile("s_waitcnt lgkmcnt(0)" ::: "memory")

struct Params;
__device__ __forceinline__ unsigned char* wsl(const Params& P);
struct Params {
    const float* x; const int* pos; const float* w_in; const float* mu; const float* w0; const float* w_up; const float* a0; const float* a_up;
    const float* k_k; const float* k_a; const float* r_k; const float* gn_g; const float* gn_b; const float* sinks;
    const float* wba; const float* wbb; const float* wbc; const float* w_out; const float* ln_g; const float* ln_b;
    float* out; unsigned char* ws;
};

__device__ __forceinline__ unsigned char* wsl(const Params& P) { unsigned char* w = P.ws; asm volatile("" : "+s"(w)); return w; }

struct Epi1 {
    static constexpr bool PERM = false, AFTER_DRAIN = false;
    unsigned char* ws;
    __device__ __forceinline__ void operator()(const f32x4 (&acc)[2][2][4][2], const Unit& u, int wr, int wc, int fr, int fq) const {
        const int pn = u.pn; const int row0 = u.pm * 256 + wr * 64 + fr;
        const float* cosT = (const float*)(ws + WS_COS); const float* sinT = (const float*)(ws + WS_SIN); float* KMEAN = (float*)(ws + WS_KMEAN); bf16_t* BND = (bf16_t*)(ws + WS_BND);
#pragma unroll
        for (int bj = 0; bj < 2; ++bj) {
            int kind = 0; size_t doff = 0; constexpr int pitch = 512; int cb = 0; float sc = 1.f; int bcol = -1; const int tcol = 128 * bj;
            if (pn < 12) { doff = WS_QA + (size_t)(pn >> 1) * (16 * MiB); cb = (pn & 1) * 256 + tcol; kind = pn < 4 ? 1 : 0; if (pn < 2) sc = C2F; if (pn >= 6) bcol = ((pn - 6) >> 1) * 512 + cb; }
            else if (pn == 12) { if (bj == 0) { doff = WS_MISC; cb = 256; bcol = 1536; } else kind = 2; }
            else if (pn < 15) { kind = 1; doff = WS_QC; cb = (pn - 13) * 256 + tcol; sc = C2F; }
            else { doff = WS_MISC; if (bj == 0) { kind = 1; cb = 0; } else { cb = 128; } }
            bf16_t* dst = (bf16_t*)(ws + doff);
            if (kind == 2) continue;
            if (kind == 0) {
#pragma unroll
                for (int ai = 0; ai < 2; ++ai)
#pragma unroll
                    for (int m = 0; m < 4; ++m) { const int row = row0 + ai * 128 + m * 16;
#pragma unroll
                        for (int n = 0; n < 2; ++n) { const f32x4 v = acc[ai][bj][m][n]; u32x2 w; w.x = pk2(v[0], v[1]); w.y = pk2(v[2], v[3]);
                            const int c = 32 * wc + 16 * n + 4 * fq;
                            *(u32x2*)(dst + (unsigned)(row * pitch + cb + c)) = w;
                            if (bcol >= 0 && m == 3 && fr == 15) *(u32x2*)(BND + (unsigned)((row >> 6) * 1664 + bcol + c)) = w; }
                        asm volatile("" ::: "memory"); }
            } else {
                const int f0 = 16 * (wc & 1) + 4 * fq; const int c1 = cb + 64 * (wc >> 1) + f0;
                const bool km = (pn == 2 || pn == 3);
                f32x4 s1 = {0.f, 0.f, 0.f, 0.f}, s2 = {0.f, 0.f, 0.f, 0.f};
#pragma unroll
                for (int ai = 0; ai < 2; ++ai)
#pragma unroll
                    for (int m = 0; m < 4; ++m) { const int row = row0 + ai * 128 + m * 16;
                        const f32x4 cs = *(const f32x4*)(cosT + (unsigned)(row * 32 + f0)), sn = *(const f32x4*)(sinT + (unsigned)(row * 32 + f0));
                        const f32x4 x1 = acc[ai][bj][m][0], x2 = acc[ai][bj][m][1];
                        const f32x4 o1 = x1 * cs - x2 * sn, o2 = x2 * cs + x1 * sn;
                        s1 += o1; s2 += o2;
                        u32x2 w; w.x = pk2(o1[0] * sc, o1[1] * sc); w.y = pk2(o1[2] * sc, o1[3] * sc);
                        *(u32x2*)(dst + (unsigned)(row * pitch + c1)) = w;
                        w.x = pk2(o2[0] * sc, o2[1] * sc); w.y = pk2(o2[2] * sc, o2[3] * sc);
                        *(u32x2*)(dst + (unsigned)(row * pitch + c1 + 32)) = w;
                        asm volatile("" ::: "memory"); }
                if (km) {
#pragma unroll
                    for (int j = 0; j < 4; ++j) {
                        float a = s1[j], b = s2[j];
#pragma unroll
                        for (int o = 1; o < 16; o <<= 1) { a += __shfl_xor(a, o); b += __shfl_xor(b, o); }
                        if (fr == 0) { atomicAdd(KMEAN + (unsigned)(u.pm * 512 + c1 + j), a); atomicAdd(KMEAN + (unsigned)(u.pm * 512 + c1 + 32 + j), b); }
                    }
                }
            }
        }
    }
};

struct EpiZ {
    static constexpr bool PERM = false, AFTER_DRAIN = false;
    unsigned char* ws;
    __device__ __forceinline__ void operator()(const f32x4 (&acc)[2][2][4][2], const Unit& u, int wr, int wc, int fr, int fq) const {
        const int br = u.pn >> 1; bf16_t* O = (bf16_t*)(ws + (br == 0 ? WS_QA : (br == 1 ? WS_DW : WS_QC)));
        const int row0 = u.pm * 256 + wr * 64 + fr; const int cb = (u.pn & 1) * 256 + 32 * wc + 4 * fq;
#pragma unroll
        for (int ai = 0; ai < 2; ++ai)
#pragma unroll
            for (int m = 0; m < 4; ++m) { const int row = row0 + ai * 128 + m * 16;
#pragma unroll
                for (int bj = 0; bj < 2; ++bj)
#pragma unroll
                    for (int n = 0; n < 2; ++n) { const f32x4 z = acc[ai][bj][m][n]; u32x2* p = (u32x2*)(O + (unsigned)(row * 512 + cb + 128 * bj + 16 * n));
                        u32x2 w;
                        if (br == 1) { w.x = pk2(z[0], z[1]); w.y = pk2(z[2], z[3]); }
                        else { const u32x2 o = *p;
                            w.x = pk2(bflo(o.x) * z[0] * sigmoidf_(z[0]), bfhi(o.x) * z[1] * sigmoidf_(z[1]));
                            w.y = pk2(bflo(o.y) * z[2] * sigmoidf_(z[2]), bfhi(o.y) * z[3] * sigmoidf_(z[3])); }
                        *p = w; }
                asm volatile("" ::: "memory"); }
    }
};

struct EpiY {
    static constexpr bool PERM = false, AFTER_DRAIN = false;
    bf16_t* Y;
    __device__ __forceinline__ void operator()(const f32x4 (&acc)[2][2][4][2], const Unit& u, int wr, int wc, int fr, int fq) const {
        const int row0 = u.pm * 256 + wr * 64 + fr; const int cb = u.pn * 256 + 32 * wc + 4 * fq;
#pragma unroll
        for (int ai = 0; ai < 2; ++ai)
#pragma unroll
            for (int m = 0; m < 4; ++m) { const int row = row0 + ai * 128 + m * 16;
#pragma unroll
                for (int bj = 0; bj < 2; ++bj)
#pragma unroll
                    for (int n = 0; n < 2; ++n) { const f32x4 v = acc[ai][bj][m][n]; u32x2 w; w.x = pk2(v[0], v[1]); w.y = pk2(v[2], v[3]);
                        *(u32x2*)(Y + (unsigned)(row * 1024 + cb + 128 * bj + 16 * n)) = w; } }
    }
};

struct EpiG {
    static constexpr bool PERM = false, AFTER_DRAIN = false;
    const bf16_t* Y; bf16_t* MG; int first;
    __device__ __forceinline__ void operator()(const f32x4 (&acc)[2][2][4][2], const Unit& u, int wr, int wc, int fr, int fq) const {
        const int row0 = u.pm * 256 + wr * 64 + fr; const int cb = u.pn * 256 + 32 * wc + 4 * fq;
#pragma unroll
        for (int ai = 0; ai < 2; ++ai)
#pragma unroll
            for (int m = 0; m < 4; ++m) { const int row = row0 + ai * 128 + m * 16;
#pragma unroll
                for (int bj = 0; bj < 2; ++bj)
#pragma unroll
                    for (int n = 0; n < 2; ++n) { const f32x4 g = acc[ai][bj][m][n]; const unsigned off = (unsigned)(row * 1024 + cb + 128 * bj + 16 * n);
                        const u32x2 y = *(const u32x2*)(Y + off); u32x2 mg = {0u, 0u}; if (!first) mg = *(const u32x2*)(MG + off);
                        u32x2 w;
                        w.x = pk2(bflo(mg.x) + sigmoidf_(g[0]) * bflo(y.x), bfhi(mg.x) + sigmoidf_(g[1]) * bfhi(y.x));
                        w.y = pk2(bflo(mg.y) + sigmoidf_(g[2]) * bflo(y.y), bfhi(mg.y) + sigmoidf_(g[3]) * bfhi(y.y));
                        *(u32x2*)(MG + off) = w; }
                asm volatile("" ::: "memory"); }
    }
};

struct EpiOut {
    static constexpr bool PERM = false, AFTER_DRAIN = false;
    const float* xres; float* out;
    __device__ __forceinline__ void operator()(const f32x4 (&acc)[2][2][4][2], const Unit& u, int wr, int wc, int fr, int fq) const {
        const int row0 = u.pm * 256 + wr * 64 + fr; const int cb = u.pn * 256 + 32 * wc + 4 * fq;
#pragma unroll
        for (int ai = 0; ai < 2; ++ai)
#pragma unroll
            for (int m = 0; m < 4; ++m) { const int row = row0 + ai * 128 + m * 16;
#pragma unroll
                for (int bj = 0; bj < 2; ++bj)
#pragma unroll
                    for (int n = 0; n < 2; ++n) { const unsigned off = (unsigned)(row * 1024 + cb + 128 * bj + 16 * n);
                        const f32x4 xr = *(const f32x4*)(xres + off); *(f32x4*)(out + off) = xr * ALPHA_RES + acc[ai][bj][m][n]; }
                asm volatile("" ::: "memory"); }
    }
};

struct EpiAll {
    static constexpr bool PERM = false, AFTER_DRAIN = false;
    Epi1 e1; EpiZ ez; EpiY ey; EpiG eg; EpiOut eo; int mode;
    __device__ __forceinline__ void operator()(const f32x4 (&acc)[2][2][4][2], const Unit& u, int wr, int wc, int fr, int fq) const {
        if (mode == 0) e1(acc, u, wr, wc, fr, fq);
        else if (mode == 1) ez(acc, u, wr, wc, fr, fq);
        else if (mode == 2) ey(acc, u, wr, wc, fr, fq);
        else if (mode == 3) eg(acc, u, wr, wc, fr, fq);
        else eo(acc, u, wr, wc, fr, fq);
    }
};

__device__ __forceinline__ int rope_perm(int q) { const int hd = q >> 6, r = q & 63; return hd * 64 + 16 * (r >> 5) + (r & 15) + 32 * ((r >> 4) & 1); }
__device__ __forceinline__ int win_map(int p) {
    if (p < 4096) {
        const int t = p >> 8, q = p & 255;
        if (t < 2) return t * 256 + rope_perm(q);
        if (t < 4) return 512 + (t - 2) * 256 + rope_perm(q);
        if (t < 6) return 1024 + (t - 4) * 256 + q;
        if (t < 8) return 2048 + (t - 6) * 256 + q;
        if (t < 10) return 2560 + (t - 8) * 256 + q;
        if (t < 12) return 3072 + (t - 10) * 256 + q;
        if (t == 12) return q < 128 ? 3584 + q : -1;
        if (t < 15) return 4224 + (t - 13) * 256 + rope_perm(q);
        return q < 128 ? 4736 + rope_perm(q) : 4864 + (q - 128);
    }
    if (p < 5632) { const int q = p - 4096, br = q >> 9, c = q & 511; return br == 0 ? 1536 + c : (br == 1 ? 3712 + c : 4992 + c); }
    return 5504 + (p - 5632);
}
__device__ __forceinline__ void transpose_item(const float* W, int Nsrc, bf16_t* WT, int K, int k0, int p0, int srccol, LAS float* scr, int lane) {
#pragma unroll 8
    for (int i = 0; i < 32; ++i) { const int kk = 2 * i + (lane >> 5); scr[kk * 33 + (lane & 31)] = srccol >= 0 ? W[(size_t)(k0 + kk) * Nsrc + srccol] : 0.f; }
    LDS_WAIT();
    const int c = lane & 7;
#pragma unroll
    for (int j = 0; j < 4; ++j) { const int n = (lane >> 3) + 8 * j; const LAS float* s = scr + (8 * c) * 33 + n;
        u32x4 o; o.x = pk2(s[0 * 33], s[1 * 33]); o.y = pk2(s[2 * 33], s[3 * 33]); o.z = pk2(s[4 * 33], s[5 * 33]); o.w = pk2(s[6 * 33], s[7 * 33]);
        *(u32x4*)(WT + (size_t)(p0 + n) * K + k0 + 8 * c) = o; }
    LDS_WAIT();
}
__device__ __forceinline__ float wave_sum(float v) {
#pragma unroll
    for (int o = 1; o < 64; o <<= 1) v += __shfl_xor(v, o);
    return v;
}
__device__ __forceinline__ void row_to_bf16(const float* src, float* dst_f32, bf16_t* dst_bf, const float* g, const float* b, bool do_ln, int lane) {
    const f32x4* xr = (const f32x4*)src + lane;
    f32x4 v[4]; float s = 0.f;
#pragma unroll
    for (int j = 0; j < 4; ++j) { v[j] = xr[64 * j]; s += (v[j][0] + v[j][1]) + (v[j][2] + v[j][3]); }
    if (do_ln) {
        const float mean = wave_sum(s) * (1.f / 1024.f); float s2 = 0.f;
#pragma unroll
        for (int j = 0; j < 4; ++j) { v[j] = v[j] - mean; s2 += (v[j][0] * v[j][0] + v[j][1] * v[j][1]) + (v[j][2] * v[j][2] + v[j][3] * v[j][3]); }
        const float rstd = 1.0f / sqrtf(wave_sum(s2) * (1.f / 1024.f) + 1e-5f);
#pragma unroll
        for (int j = 0; j < 4; ++j) { const f32x4 gg = ((const f32x4*)g)[lane + 64 * j], bb = ((const f32x4*)b)[lane + 64 * j]; v[j] = v[j] * rstd * gg + bb; }
        if (dst_f32) {
#pragma unroll
            for (int j = 0; j < 4; ++j) ((f32x4*)dst_f32)[lane + 64 * j] = v[j];
        }
    }
    if (dst_bf) {
#pragma unroll
        for (int j = 0; j < 4; ++j) { u32x2 w; w.x = pk2(v[j][0], v[j][1]); w.y = pk2(v[j][2], v[j][3]); ((u32x2*)dst_bf)[lane + 64 * j] = w; }
    }
}

constexpr int KS_PITCH = 144, VT_PITCH = 80, VT_TILE = 64 * 80;
constexpr int ALDS_K = 0, ALDS_V = 55296, ALDS_KM = 116736, ALDS_SEL = 124672;

template <class MaskF>
__device__ __forceinline__ void attn_tile(const LAS unsigned char* Kt, const LAS unsigned char* Vt, const bf16x8 (&qf)[4], float& m, float& l, f32x16& o0, f32x16& o1,
                                          int r32, int hi, bool masked, MaskF valid) {
    f32x16 s;
#pragma unroll
    for (int r = 0; r < 16; ++r) s[r] = 0.f;
#pragma unroll
    for (int ks = 0; ks < 4; ++ks) { const bf16x8 a = *(const LAS bf16x8*)(Kt + r32 * KS_PITCH + (ks * 16 + hi * 8) * 2); s = __builtin_amdgcn_mfma_f32_32x32x16_bf16(a, qf[ks], s, 0, 0, 0); }
    if (masked) {
#pragma unroll
        for (int r = 0; r < 16; ++r) if (!valid(crow(r, hi))) s[r] = NEGF;
    }
    float mx = s[0];
#pragma unroll
    for (int r = 1; r < 16; ++r) mx = fmaxf(mx, s[r]);
    mx = fmaxf(mx, __shfl_xor(mx, 32));
    const float mn = fmaxf(m, mx); const float alpha = __builtin_amdgcn_exp2f(m - mn); m = mn;
    float ps = 0.f;
#pragma unroll
    for (int r = 0; r < 16; ++r) { s[r] = __builtin_amdgcn_exp2f(s[r] - mn); ps += s[r]; }
    l = l * alpha + ps;
#pragma unroll
    for (int r = 0; r < 16; ++r) { o0[r] *= alpha; o1[r] *= alpha; }
#pragma unroll
    for (int s2 = 0; s2 < 2; ++s2) {
        u32x4 pw; pw.x = pk2(s[8 * s2 + 0], s[8 * s2 + 1]); pw.y = pk2(s[8 * s2 + 2], s[8 * s2 + 3]); pw.z = pk2(s[8 * s2 + 4], s[8 * s2 + 5]); pw.w = pk2(s[8 * s2 + 6], s[8 * s2 + 7]);
        const bf16x8 pb = __builtin_bit_cast(bf16x8, pw);
        { const LAS unsigned char* vp = Vt + r32 * VT_PITCH + (16 * s2 + 4 * hi) * 2; const u32x2 lo = *(const LAS u32x2*)vp, hh = *(const LAS u32x2*)(vp + 16);
          u32x4 aw; aw.x = lo.x; aw.y = lo.y; aw.z = hh.x; aw.w = hh.y; o0 = __builtin_amdgcn_mfma_f32_32x32x16_bf16(__builtin_bit_cast(bf16x8, aw), pb, o0, 0, 0, 0); }
        { const LAS unsigned char* vp = Vt + (32 + r32) * VT_PITCH + (16 * s2 + 4 * hi) * 2; const u32x2 lo = *(const LAS u32x2*)vp, hh = *(const LAS u32x2*)(vp + 16);
          u32x4 aw; aw.x = lo.x; aw.y = lo.y; aw.z = hh.x; aw.w = hh.y; o1 = __builtin_amdgcn_mfma_f32_32x32x16_bf16(__builtin_bit_cast(bf16x8, aw), pb, o1, 0, 0, 0); }
    }
}
__device__ __forceinline__ void stage_kv(LAS unsigned char* lds, const bf16_t* Ksrc, const bf16_t* Vsrc, int pitch, int nkeys, int first_valid, int tid) {
    for (int i = tid; i < nkeys * 8; i += NTHR) {
        const int key = i >> 3, pc = i & 7;
        if (key < first_valid) continue;
        const u32x4 kv = *(const u32x4*)(Ksrc + (size_t)key * pitch + pc * 8);
        *(LAS u32x4*)(lds + ALDS_K + key * KS_PITCH + pc * 16) = kv;
    }
    for (int i = tid; i < nkeys * 8; i += NTHR) {
        const int key = i % nkeys, pc = i / nkeys;
        if (key < first_valid) continue;
        const u32x4 vv = *(const u32x4*)(Vsrc + (size_t)key * pitch + pc * 8);
        LAS unsigned short* vt = (LAS unsigned short*)(lds + ALDS_V + (key >> 5) * VT_TILE + (pc * 8) * VT_PITCH + (key & 31) * 2);
        vt[0 * 40] = (unsigned short)(vv.x & 0xffffu); vt[1 * 40] = (unsigned short)(vv.x >> 16);
        vt[2 * 40] = (unsigned short)(vv.y & 0xffffu); vt[3 * 40] = (unsigned short)(vv.y >> 16);
        vt[4 * 40] = (unsigned short)(vv.z & 0xffffu); vt[5 * 40] = (unsigned short)(vv.z >> 16);
        vt[6 * 40] = (unsigned short)(vv.w & 0xffffu); vt[7 * 40] = (unsigned short)(vv.w >> 16);
    }
}
__device__ __forceinline__ void attn_store(bf16_t* O, int pitch, const f32x16& o0, const f32x16& o1, float inv, int hi) {
#pragma unroll
    for (int g = 0; g < 4; ++g) {
        u32x2 w; w.x = pk2(o0[4 * g] * inv, o0[4 * g + 1] * inv); w.y = pk2(o0[4 * g + 2] * inv, o0[4 * g + 3] * inv);
        *(u32x2*)(O + 8 * g + 4 * hi) = w;
        w.x = pk2(o1[4 * g] * inv, o1[4 * g + 1] * inv); w.y = pk2(o1[4 * g + 2] * inv, o1[4 * g + 3] * inv);
        *(u32x2*)(O + 32 + 8 * g + 4 * hi) = w;
    }
}

__device__ __forceinline__ void moba_item(unsigned char* ldsg, LAS unsigned char* lds, const Params& P, int b, int h, int n) {
    const int tid = tid_l(), lane = tid & 63, r32 = lane & 31, hi = lane >> 5; const int w = __builtin_amdgcn_readfirstlane(tid >> 6);
    bf16_t* QA = (bf16_t*)(wsl(P) + WS_QA); const bf16_t* KA = (const bf16_t*)(wsl(P) + WS_KA); const bf16_t* VA = (const bf16_t*)(wsl(P) + WS_VA);
    const float* KMEAN = (const float*)(wsl(P) + WS_KMEAN);
    const size_t rowbase = (size_t)b * SEQL + (size_t)n * 256;
    LAS float* KM = (LAS float*)(lds + ALDS_KM); LAS int* SEL = (LAS int*)(lds + ALDS_SEL);
    __syncthreads();
    for (int i = tid; i < n * 64; i += NTHR) KM[i] = KMEAN[(size_t)(b * 32 + (i >> 6)) * 512 + h * 64 + (i & 63)];
    __syncthreads();
    if (tid < 256) {
        int mask = 0;
        if (n <= 3) mask = (1 << n) - 1;
        else {
            float q[64];
            const u32x4* qp = (const u32x4*)(QA + (rowbase + tid) * 512 + h * 64);
#pragma unroll
            for (int i = 0; i < 8; ++i) { const u32x4 t = qp[i]; q[8 * i] = bflo(t.x); q[8 * i + 1] = bfhi(t.x); q[8 * i + 2] = bflo(t.y); q[8 * i + 3] = bfhi(t.y); q[8 * i + 4] = bflo(t.z); q[8 * i + 5] = bfhi(t.z); q[8 * i + 6] = bflo(t.w); q[8 * i + 7] = bfhi(t.w); }
            float v1 = -3.0e38f, v2 = -3.0e38f, v3 = -3.0e38f; int i1 = 0, i2 = 0, i3 = 0;
            for (int j = 0; j < n; ++j) {
                float g0 = 0.f, g1 = 0.f, g2 = 0.f, g3 = 0.f;
#pragma unroll
                for (int d = 0; d < 64; d += 4) { const f32x4 kmv = *(const LAS f32x4*)(KM + j * 64 + d); g0 += q[d] * kmv[0]; g1 += q[d + 1] * kmv[1]; g2 += q[d + 2] * kmv[2]; g3 += q[d + 3] * kmv[3]; }
                const float g = (g0 + g1) + (g2 + g3);
                if (g > v1) { v3 = v2; i3 = i2; v2 = v1; i2 = i1; v1 = g; i1 = j; }
                else if (g > v2) { v3 = v2; i3 = i2; v2 = g; i2 = j; }
                else if (g > v3) { v3 = g; i3 = j; }
            }
            mask = (1 << i1) | (1 << i2) | (1 << i3);
        }
        SEL[tid] = mask;
    }
    __syncthreads();
    const int sel = SEL[w * 32 + r32];
    bf16x8 qf[4];
    { const bf16_t* qrow = QA + (rowbase + w * 32 + r32) * 512 + h * 64;
#pragma unroll
      for (int ks = 0; ks < 4; ++ks) qf[ks] = *(const bf16x8*)(qrow + ks * 16 + hi * 8); }
    float m = NEGF, l = 0.f; f32x16 o0, o1;
#pragma unroll
    for (int r = 0; r < 16; ++r) { o0[r] = 0.f; o1[r] = 0.f; }
    for (int j = 0; j <= n; ++j) {
        __syncthreads();
        stage_kv(lds, KA + ((size_t)b * SEQL + (size_t)j * 256) * 512 + h * 64, VA + ((size_t)b * SEQL + (size_t)j * 256) * 512 + h * 64, 512, 256, 0, tid);
        __syncthreads();
        if (j < n) {
            const bool mine = (sel >> j) & 1;
            if (__any(mine)) {
                for (int t = 0; t < 8; ++t)
                    attn_tile(lds + ALDS_K + t * 32 * KS_PITCH, lds + ALDS_V + t * VT_TILE, qf, m, l, o0, o1, r32, hi, true, [&](int) { return mine; });
            }
        } else {
            for (int t = 0; t <= w; ++t)
                attn_tile(lds + ALDS_K + t * 32 * KS_PITCH, lds + ALDS_V + t * VT_TILE, qf, m, l, o0, o1, r32, hi, t == w, [&](int kc) { return kc <= r32; });
        }
    }
    const float lt = l + __shfl_xor(l, 32);
    attn_store(QA + (rowbase + w * 32 + r32) * 512 + h * 64, 512, o0, o1, 1.0f / lt, hi);
}

__device__ __forceinline__ void swa_item(LAS unsigned char* lds, const Params& P, int layer, int b, int qh, int blk) {
    const int tid = tid_l(), lane = tid & 63, r32 = lane & 31, hi = lane >> 5; const int w = __builtin_amdgcn_readfirstlane(tid >> 6);
    bf16_t* QC = (bf16_t*)(wsl(P) + WS_QC); const bf16_t* KC = (const bf16_t*)(wsl(P) + WS_MISC); const bf16_t* VC = KC + 128;
    const int Q0 = blk * 256, kvh = qh >> 2;
    const size_t rowq = (size_t)b * SEQL + Q0 + w * 32 + r32;
    bf16x8 qf[4];
    { const bf16_t* qrow = QC + rowq * 512 + qh * 64;
#pragma unroll
      for (int ks = 0; ks < 4; ++ks) qf[ks] = *(const bf16x8*)(qrow + ks * 16 + hi * 8); }
    __syncthreads();
    const long kbase = (long)b * SEQL + Q0 - 128;
    stage_kv(lds, KC + kbase * 512 + kvh * 64, VC + kbase * 512 + kvh * 64, 512, 384, blk == 0 ? 128 : 0, tid);
    __syncthreads();
    float m = NEGF, l = 0.f; f32x16 o0, o1;
#pragma unroll
    for (int r = 0; r < 16; ++r) { o0[r] = 0.f; o1[r] = 0.f; }
    for (int tt = w; tt <= w + 4; ++tt) {
        if (blk == 0 && tt < 4) continue;
        if (tt == w) attn_tile(lds + ALDS_K + tt * 32 * KS_PITCH, lds + ALDS_V + tt * VT_TILE, qf, m, l, o0, o1, r32, hi, true, [&](int kc) { return kc > r32; });
        else if (tt == w + 4) attn_tile(lds + ALDS_K + tt * 32 * KS_PITCH, lds + ALDS_V + tt * VT_TILE, qf, m, l, o0, o1, r32, hi, true, [&](int kc) { return kc <= r32; });
        else attn_tile(lds + ALDS_K + tt * 32 * KS_PITCH, lds + ALDS_V + tt * VT_TILE, qf, m, l, o0, o1, r32, hi, false, [&](int) { return true; });
    }
    const float sk = P.sinks[layer * 8 + qh] * LOG2E;
    const float mn = fmaxf(m, sk); const float alpha = __builtin_amdgcn_exp2f(m - mn);
    const float lt = (l + __shfl_xor(l, 32)) * alpha + __builtin_amdgcn_exp2f(sk - mn);
    attn_store(QC + rowq * 512 + qh * 64, 512, o0, o1, alpha / lt, hi);
}

__device__ __forceinline__ void rwkv_prepass_item(LAS unsigned char* lds, const Params& P, int layer, int T, int h) {
    const int tid = tid_l(), tok = tid >> 3, c8 = tid & 7;
    bf16_t* RB = (bf16_t*)(wsl(P) + WS_RB); bf16_t* KB = (bf16_t*)(wsl(P) + WS_KB); bf16_t* VB = (bf16_t*)(wsl(P) + WS_VB);
    const bf16_t* LORA = (const bf16_t*)(wsl(P) + WS_MISC) + 256; const bf16_t* BND = (const bf16_t*)(wsl(P) + WS_BND);
    bf16_t* DW = (bf16_t*)(wsl(P) + WS_DW); bf16_t* KK = (bf16_t*)(wsl(P) + WS_KK); bf16_t* BB = (bf16_t*)(wsl(P) + WS_BB); float* RK = (float*)(wsl(P) + WS_RK);
    const float* mu = P.mu + layer * 2176;
    LAS float* L = (LAS float*)lds;
    LAS float* WU = (LAS float*)(lds + 32768);
    LAS float* AU = (LAS float*)(lds + 49152);
    const size_t row = (size_t)T * 64 + tok; const bool seq0 = ((row & (SEQL - 1)) == 0); const bool tile0 = (tok == 0);
    const int ch = h * 64 + c8 * 8;
    __syncthreads();
    u32x4 rc = *(const u32x4*)(RB + row * 512 + ch), kc = *(const u32x4*)(KB + row * 512 + ch), vc = *(const u32x4*)(VB + row * 512 + ch);
    u32x4 rp = {0u, 0u, 0u, 0u}, kp = rp, vp = rp;
    u32x4 lc0 = *(const u32x4*)(LORA + row * 512 + c8 * 16), lc1 = *(const u32x4*)(LORA + row * 512 + c8 * 16 + 8), lp0 = rp, lp1 = rp;
    if (!seq0) {
        if (tile0) { const bf16_t* bp = BND + (size_t)(T - 1) * 1664;
            rp = *(const u32x4*)(bp + ch); kp = *(const u32x4*)(bp + 512 + ch); vp = *(const u32x4*)(bp + 1024 + ch); lp0 = *(const u32x4*)(bp + 1536 + c8 * 16); lp1 = *(const u32x4*)(bp + 1536 + c8 * 16 + 8); }
        else { rp = *(const u32x4*)(RB + (row - 1) * 512 + ch); kp = *(const u32x4*)(KB + (row - 1) * 512 + ch); vp = *(const u32x4*)(VB + (row - 1) * 512 + ch);
            lp0 = *(const u32x4*)(LORA + (row - 1) * 512 + c8 * 16); lp1 = *(const u32x4*)(LORA + (row - 1) * 512 + c8 * 16 + 8); }
    }
    {
        const unsigned cw[8] = {lc0.x, lc0.y, lc0.z, lc0.w, lc1.x, lc1.y, lc1.z, lc1.w}; const unsigned pw[8] = {lp0.x, lp0.y, lp0.z, lp0.w, lp1.x, lp1.y, lp1.z, lp1.w};
#pragma unroll
        for (int i = 0; i < 8; ++i) {
            const int col = c8 * 16 + 2 * i;
            const float m0 = mu[1536 + col], m1 = mu[1536 + col + 1];
            float a = bflo(cw[i]), bq = bfhi(cw[i]); a = a + (bflo(pw[i]) - a) * m0; bq = bq + (bfhi(pw[i]) - bq) * m1;
            if (col < 64) { a = tanhf(a); bq = tanhf(bq); }
            L[tok * 128 + col] = a; L[tok * 128 + col + 1] = bq;
        }
    }
    for (int i = tid; i < 4096; i += NTHR) { WU[i] = P.w_up[(size_t)layer * 64 * 512 + (size_t)(i >> 6) * 512 + h * 64 + (i & 63)]; AU[i] = P.a_up[(size_t)layer * 64 * 512 + (size_t)(i >> 6) * 512 + h * 64 + (i & 63)]; }
    __syncthreads();
    float aw[8], aa[8];
#pragma unroll
    for (int i = 0; i < 8; ++i) { aw[i] = 0.f; aa[i] = 0.f; }
    for (int j = 0; j < 64; ++j) {
        const float lw = L[tok * 128 + j], la = L[tok * 128 + 64 + j];
        const f32x4 w0v = *(const LAS f32x4*)(WU + j * 64 + c8 * 8), w1v = *(const LAS f32x4*)(WU + j * 64 + c8 * 8 + 4);
        const f32x4 a0v = *(const LAS f32x4*)(AU + j * 64 + c8 * 8), a1v = *(const LAS f32x4*)(AU + j * 64 + c8 * 8 + 4);
#pragma unroll
        for (int i = 0; i < 4; ++i) { aw[i] += lw * w0v[i]; aw[4 + i] += lw * w1v[i]; aa[i] += la * a0v[i]; aa[4 + i] += la * a1v[i]; }
    }
    const unsigned rcw[4] = {rc.x, rc.y, rc.z, rc.w}, rpw[4] = {rp.x, rp.y, rp.z, rp.w}, kcw[4] = {kc.x, kc.y, kc.z, kc.w}, kpw[4] = {kp.x, kp.y, kp.z, kp.w}, vcw[4] = {vc.x, vc.y, vc.z, vc.w}, vpw[4] = {vp.x, vp.y, vp.z, vp.w};
    float rs[8], ks[8], vs[8], kkr[8], av[8], dw[8];
    float ss = 0.f;
#pragma unroll
    for (int i = 0; i < 8; ++i) {
        const int c = ch + i; const int wi = i >> 1; const bool hiw = i & 1;
        const float r0 = hiw ? bfhi(rcw[wi]) : bflo(rcw[wi]), r1 = hiw ? bfhi(rpw[wi]) : bflo(rpw[wi]);
        const float k0 = hiw ? bfhi(kcw[wi]) : bflo(kcw[wi]), k1 = hiw ? bfhi(kpw[wi]) : bflo(kpw[wi]);
        const float v0 = hiw ? bfhi(vcw[wi]) : bflo(vcw[wi]), v1 = hiw ? bfhi(vpw[wi]) : bflo(vpw[wi]);
        rs[i] = r0 + (r1 - r0) * mu[c]; ks[i] = k0 + (k1 - k0) * mu[512 + c]; vs[i] = v0 + (v1 - v0) * mu[1024 + c];
        const float sg = sigmoidf_(P.w0[layer * 512 + c] + aw[i]);
        dw[i] = 1.0f - __expf(-0.6065306597126334f * sg);
        av[i] = sigmoidf_(P.a0[layer * 512 + c] + aa[i]);
        kkr[i] = ks[i] * P.k_k[layer * 512 + c]; ss += kkr[i] * kkr[i];
    }
    ss += __shfl_xor(ss, 1); ss += __shfl_xor(ss, 2); ss += __shfl_xor(ss, 4);
    const float inv = 1.0f / fmaxf(sqrtf(ss), 1e-12f);
    float kq[8], kkn[8], bbv[8]; float rk = 0.f;
#pragma unroll
    for (int i = 0; i < 8; ++i) { const int c = ch + i; kkn[i] = kkr[i] * inv; kq[i] = ks[i] * (1.0f + (av[i] - 1.0f) * P.k_a[layer * 512 + c]); bbv[i] = kkn[i] * av[i]; rk += rs[i] * kq[i] * P.r_k[layer * 512 + c]; }
    rk += __shfl_xor(rk, 1); rk += __shfl_xor(rk, 2); rk += __shfl_xor(rk, 4);
    if (c8 == 0) RK[row * 8 + h] = rk;
    u32x4 o;
    o.x = pk2(rs[0], rs[1]); o.y = pk2(rs[2], rs[3]); o.z = pk2(rs[4], rs[5]); o.w = pk2(rs[6], rs[7]); *(u32x4*)(RB + row * 512 + ch) = o;
    o.x = pk2(kq[0], kq[1]); o.y = pk2(kq[2], kq[3]); o.z = pk2(kq[4], kq[5]); o.w = pk2(kq[6], kq[7]); *(u32x4*)(KB + row * 512 + ch) = o;
    o.x = pk2(vs[0], vs[1]); o.y = pk2(vs[2], vs[3]); o.z = pk2(vs[4], vs[5]); o.w = pk2(vs[6], vs[7]); *(u32x4*)(VB + row * 512 + ch) = o;
    o.x = pk2(dw[0], dw[1]); o.y = pk2(dw[2], dw[3]); o.z = pk2(dw[4], dw[5]); o.w = pk2(dw[6], dw[7]); *(u32x4*)(DW + row * 512 + ch) = o;
    o.x = pk2(kkn[0], kkn[1]); o.y = pk2(kkn[2], kkn[3]); o.z = pk2(kkn[4], kkn[5]); o.w = pk2(kkn[6], kkn[7]); *(u32x4*)(KK + row * 512 + ch) = o;
    o.x = pk2(bbv[0], bbv[1]); o.y = pk2(bbv[2], bbv[3]); o.z = pk2(bbv[4], bbv[5]); o.w = pk2(bbv[6], bbv[7]); *(u32x4*)(BB + row * 512 + ch) = o;
}

constexpr int SC_T = 32, SC_ARR = SC_T * 64 * 4, SC_BUF = 6 * SC_ARR;
__device__ __forceinline__ void rwkv_scan(LAS unsigned char* lds, const Params& P, int b, int h) {
    const int tid = tid_l(), lane = tid & 63, p = lane & 7; const int w = tid >> 6; const int irow = w * 8 + (lane >> 3);
    const bf16_t* src[6] = {(const bf16_t*)(wsl(P) + WS_DW), (const bf16_t*)(wsl(P) + WS_KK), (const bf16_t*)(wsl(P) + WS_BB), (const bf16_t*)(wsl(P) + WS_KB), (const bf16_t*)(wsl(P) + WS_RB), (const bf16_t*)(wsl(P) + WS_VB)};
    bf16_t* OB = (bf16_t*)(wsl(P) + WS_OB);
    const size_t row0 = (size_t)b * SEQL; const int hc = h * 64;
    float s[8];
#pragma unroll
    for (int i = 0; i < 8; ++i) s[i] = 0.f;
    u32x4 stg[3];
    auto gload = [&](int tile) {
#pragma unroll
        for (int i = 0; i < 3; ++i) { const int q = tid + NTHR * i, arr = q >> 8, pc = q & 255, t = pc >> 3, c8 = pc & 7;
            const bf16_t* sp = arr == 0 ? src[0] : arr == 1 ? src[1] : arr == 2 ? src[2] : arr == 3 ? src[3] : arr == 4 ? src[4] : src[5];
            stg[i] = *(const u32x4*)(sp + (row0 + (size_t)tile * SC_T + t) * 512 + hc + c8 * 8); }
    };
    auto lstore = [&](int buf) {
#pragma unroll
        for (int i = 0; i < 3; ++i) { const int q = tid + NTHR * i, arr = q >> 8, pc = q & 255, t = pc >> 3, c8 = pc & 7;
            f32x4 a, c; a[0] = bflo(stg[i].x); a[1] = bfhi(stg[i].x); a[2] = bflo(stg[i].y); a[3] = bfhi(stg[i].y); c[0] = bflo(stg[i].z); c[1] = bfhi(stg[i].z); c[2] = bflo(stg[i].w); c[3] = bfhi(stg[i].w);
            if (arr == 0) { a = 1.0f - a; c = 1.0f - c; }
            LAS f32x4* d = (LAS f32x4*)(lds + buf * SC_BUF + arr * SC_ARR + (t * 64 + c8 * 8) * 4); d[0] = a; d[1] = c; }
    };
    __syncthreads();
    gload(0); lstore(0);
    __syncthreads();
    constexpr int NTILE = SEQL / SC_T;
    for (int tile = 0; tile < NTILE; ++tile) {
        const int buf = tile & 1;
        if (tile + 1 < NTILE) gload(tile + 1);
        const LAS unsigned char* B = lds + buf * SC_BUF;
#pragma unroll 2
        for (int t = 0; t < SC_T; ++t) {
            const LAS f32x4* wp = (const LAS f32x4*)(B + 0 * SC_ARR + (t * 64 + p * 8) * 4);
            const LAS f32x4* kkp = (const LAS f32x4*)(B + 1 * SC_ARR + (t * 64 + p * 8) * 4);
            const LAS f32x4* bbp = (const LAS f32x4*)(B + 2 * SC_ARR + (t * 64 + p * 8) * 4);
            const LAS f32x4* kp = (const LAS f32x4*)(B + 3 * SC_ARR + (t * 64 + p * 8) * 4);
            const LAS f32x4* rp = (const LAS f32x4*)(B + 4 * SC_ARR + (t * 64 + p * 8) * 4);
            const float v = *(const LAS float*)(B + 5 * SC_ARR + (t * 64 + irow) * 4);
            const f32x4 w0 = wp[0], w1 = wp[1], q0 = kkp[0], q1 = kkp[1], b0 = bbp[0], b1 = bbp[1], k0 = kp[0], k1 = kp[1], r0 = rp[0], r1 = rp[1];
            float sa = (s[0] * q0[0] + s[1] * q0[1]) + (s[2] * q0[2] + s[3] * q0[3]) + (s[4] * q1[0] + s[5] * q1[1]) + (s[6] * q1[2] + s[7] * q1[3]);
            sa += __shfl_xor(sa, 1); sa += __shfl_xor(sa, 2); sa += __shfl_xor(sa, 4);
            sa = -sa;
#pragma unroll
            for (int i = 0; i < 4; ++i) { s[i] = s[i] * w0[i] + sa * b0[i] + v * k0[i]; s[4 + i] = s[4 + i] * w1[i] + sa * b1[i] + v * k1[i]; }
            float y = (s[0] * r0[0] + s[1] * r0[1]) + (s[2] * r0[2] + s[3] * r0[3]) + (s[4] * r1[0] + s[5] * r1[1]) + (s[6] * r1[2] + s[7] * r1[3]);
            y += __shfl_xor(y, 1); y += __shfl_xor(y, 2); y += __shfl_xor(y, 4);
            if (p == 0) OB[(row0 + (size_t)tile * SC_T + t) * 512 + hc + irow] = (bf16_t)(pk2(y, 0.f) & 0xffffu);
        }
        if (tile + 1 < NTILE) lstore(buf ^ 1);
        __syncthreads();
    }
}
__device__ __forceinline__ void rwkv_gn_row(const Params& P, int layer, size_t row, int lane) {
    bf16_t* OB = (bf16_t*)(wsl(P) + WS_OB); const bf16_t* VB = (const bf16_t*)(wsl(P) + WS_VB); const float* RK = (const float*)(wsl(P) + WS_RK);
    const int ch = lane * 8; const int h = lane >> 3;
    const u32x4 yv = *(const u32x4*)(OB + row * 512 + ch), vv = *(const u32x4*)(VB + row * 512 + ch);
    float y[8] = {bflo(yv.x), bfhi(yv.x), bflo(yv.y), bfhi(yv.y), bflo(yv.z), bfhi(yv.z), bflo(yv.w), bfhi(yv.w)};
    const float v[8] = {bflo(vv.x), bfhi(vv.x), bflo(vv.y), bfhi(vv.y), bflo(vv.z), bfhi(vv.z), bflo(vv.w), bfhi(vv.w)};
    float s = 0.f;
#pragma unroll
    for (int i = 0; i < 8; ++i) s += y[i];
    s += __shfl_xor(s, 1); s += __shfl_xor(s, 2); s += __shfl_xor(s, 4);
    const float mean = s * (1.f / 64.f); float q = 0.f;
#pragma unroll
    for (int i = 0; i < 8; ++i) { y[i] -= mean; q += y[i] * y[i]; }
    q += __shfl_xor(q, 1); q += __shfl_xor(q, 2); q += __shfl_xor(q, 4);
    const float rstd = 1.0f / sqrtf(q * (1.f / 64.f) + 64.0f * 1e-5f);
    const float rk = RK[row * 8 + h];
    const bf16_t* ZB = (const bf16_t*)(wsl(P) + WS_DW);
    const u32x4 zc = *(const u32x4*)(ZB + row * 512 + ch); u32x4 zp = {0u, 0u, 0u, 0u};
    if ((row & (SEQL - 1)) != 0) zp = *(const u32x4*)(ZB + (row - 1) * 512 + ch);
    const float z0[8] = {bflo(zc.x), bfhi(zc.x), bflo(zc.y), bfhi(zc.y), bflo(zc.z), bfhi(zc.z), bflo(zc.w), bfhi(zc.w)};
    const float z1[8] = {bflo(zp.x), bfhi(zp.x), bflo(zp.y), bfhi(zp.y), bflo(zp.z), bfhi(zp.z), bflo(zp.w), bfhi(zp.w)};
    float o[8];
#pragma unroll
    for (int i = 0; i < 8; ++i) { const float z = z0[i] + (z1[i] - z0[i]) * P.mu[layer * 2176 + 1664 + ch + i];
        o[i] = (y[i] * rstd * P.gn_g[layer * 512 + ch + i] + P.gn_b[layer * 512 + ch + i] + rk * v[i]) * z * sigmoidf_(z); }
    u32x4 ov; ov.x = pk2(o[0], o[1]); ov.y = pk2(o[2], o[3]); ov.z = pk2(o[4], o[5]); ov.w = pk2(o[6], o[7]);
    *(u32x4*)(OB + row * 512 + ch) = ov;
}

__global__ void __launch_bounds__(NTHR, 2) hybrid_fwd(Params P) {
    extern __shared__ __attribute__((aligned(16))) unsigned char lds_raw[];
    LAS unsigned char* lds = (LAS unsigned char*)lds_raw;
    cg::grid_group grid = cg::this_grid();
    LAS int* qslot = (LAS int*)(lds + 147440);

    for (int gs = 0; gs < NLAYER * 13; ++gs) {
        const int layer = gs / 13, st = gs % 13;
        int G = gridDim.x; asm volatile("" : "+s"(G)); const int NGW = G * 8;
        const int tid = tid_l(), lane = tid & 63; const int wave = __builtin_amdgcn_readfirstlane(tid >> 6); const int gw = blockIdx.x * 8 + wave;
        unsigned char* wsb = wsl(P);
        unsigned* ctl = (unsigned*)(wsb + WS_CTL);
        bf16_t* XB = (bf16_t*)(wsb + WS_XB); bf16_t* WIN = (bf16_t*)(wsb + WS_WIN); bf16_t* WBR = (bf16_t*)(wsb + WS_WBR); bf16_t* WOUT = (bf16_t*)(wsb + WS_WOUT);
        float* cosT = (float*)(wsb + WS_COS); float* sinT = (float*)(wsb + WS_SIN); float* KMEAN = (float*)(wsb + WS_KMEAN);
        const bool is_gemm = (st == 1 || st == 4 || st >= 6);
        if (is_gemm) {
            const bf16_t* A = XB; const bf16_t* Bt = WIN; int N = 1024, K = 1024, mode = 0, br = 0;
            if (st == 1) { N = 4096; }
            else if (st == 4) { Bt = WIN + (size_t)4096 * 1024; N = 1536; mode = 1; }
            else if (st == 12) { A = (const bf16_t*)(wsl(P) + WS_MERGED); Bt = WOUT; mode = 4; }
            else { br = (st - 6) >> 1;
                if (((st - 6) & 1) == 0) { A = (const bf16_t*)(wsl(P) + (br == 0 ? WS_QA : (br == 1 ? WS_OB : WS_QC))); Bt = WBR + (size_t)br * 1024 * 512; K = 512; mode = 2; }
                else { Bt = WIN + (size_t)(5632 + br * 1024) * 1024; mode = 3; } }
            pg8::Gemm g{A, Bt, MTOK, N, K}; pg8::StaticOrder S; S.init(MTOK, N, G, (int)blockIdx.x);
            EpiAll E{Epi1{wsl(P)}, EpiZ{wsl(P)}, EpiY{(bf16_t*)(wsl(P) + WS_Y)}, EpiG{(const bf16_t*)(wsl(P) + WS_Y), (bf16_t*)(wsl(P) + WS_MERGED), br == 0 ? 1 : 0}, EpiOut{layer == 0 ? P.x : (const float*)P.out, P.out}, mode};
            pg8::gemm_phase<EpiAll, pg8::StaticOrder, true, true>(lds, g, S, E);
            __syncthreads();
        } else if (st == 0) {
            LAS float* scr = (LAS float*)(lds + wave * 16384);
            constexpr int I_IN = 16 * 272, I_BR = 8 * 32, I_OUT = 16 * 32, NIT = I_IN + 3 * I_BR + I_OUT;
            for (int it = gw; it < NIT; it += NGW) {
                int r = it;
                if (r < I_IN) { const int kb = r / 272, nb = r % 272; transpose_item(P.w_in + (size_t)layer * DM * INW, INW, WIN, 1024, kb * 64, nb * 32, win_map(nb * 32 + (lane & 31)), scr, lane); continue; }
                r -= I_IN;
                if (r < 3 * I_BR) { const int br = r / I_BR, q = r % I_BR, kb = q / 32, nb = q % 32; const float* W = (br == 0 ? P.wba : br == 1 ? P.wbb : P.wbc) + (size_t)layer * 512 * 1024;
                    transpose_item(W, 1024, WBR + (size_t)br * 1024 * 512, 512, kb * 64, nb * 32, nb * 32 + (lane & 31), scr, lane); continue; }
                r -= 3 * I_BR;
                { const int kb = r / 32, nb = r % 32; transpose_item(P.w_out + (size_t)layer * 1024 * 1024, 1024, WOUT, 1024, kb * 64, nb * 32, nb * 32 + (lane & 31), scr, lane); }
            }
            for (int m = gw; m < MTOK; m += NGW) {
                if (layer == 0) row_to_bf16(P.x + (size_t)m * DM, nullptr, XB + (size_t)m * DM, nullptr, nullptr, false, lane);
                else row_to_bf16(P.out + (size_t)m * DM, P.out + (size_t)m * DM, XB + (size_t)m * DM, P.ln_g + (layer - 1) * DM, P.ln_b + (layer - 1) * DM, true, lane);
            }
            if (layer == 0) {
                for (int i = blockIdx.x * NTHR + tid; i < MTOK * 32; i += G * NTHR) { const int m = i >> 5, f = i & 31;
                    const float inv = powf(10000.0f, -(float)f / 32.0f); const float ang = (float)P.pos[m] * inv; cosT[i] = cosf(ang); sinT[i] = sinf(ang); }
            }
            for (int i = blockIdx.x * NTHR + tid; i < 64 * 512; i += G * NTHR) KMEAN[i] = 0.f;
        } else if (st == 2) {
            unsigned* ctr = ctl + 64 * (1 + layer * 4);
            for (;;) {
                __syncthreads();
                if (tid == 0) *qslot = (int)atomicAdd(ctr, 1u);
                __syncthreads();
                const int it = *qslot;
                if (it >= 2048 + 512) break;
                if (it < 512) { const int b = it >> 8, qh = (it >> 5) & 7, blk = it & 31; swa_item(lds, P, layer, b, qh, blk); }
                else { const int q = it - 512; rwkv_prepass_item(lds, P, layer, q >> 3, q & 7); }
            }
        } else if (st == 3) {
            if (blockIdx.x < 16) rwkv_scan(lds, P, blockIdx.x >> 3, blockIdx.x & 7);
            unsigned* ctr = ctl + 64 * (2 + layer * 4);
            for (;;) {
                __syncthreads();
                if (tid == 0) *qslot = (int)atomicAdd(ctr, 1u);
                __syncthreads();
                const int it = *qslot;
                if (it >= 512) break;
                const int n = 31 - (it >> 4), bh = it & 15;
                moba_item(lds_raw, lds, P, bh >> 3, bh & 7, n);
            }
        } else {
            for (int m = gw; m < MTOK; m += NGW) rwkv_gn_row(P, layer, (size_t)m, lane);
        }
        if (!(st >= 6 && st <= 10)) grid.sync();
    }
    { const int tid = tid_l(), lane = tid & 63; const int gw = blockIdx.x * 8 + (tid >> 6); const int NGW = gridDim.x * 8;
      for (int m = gw; m < MTOK; m += NGW) row_to_bf16(P.out + (size_t)m * DM, P.out + (size_t)m * DM, nullptr, P.ln_g + DM, P.ln_b + DM, true, lane); }
}

extern "C" void kernel_launch(void* const* d_in, const int* in_sizes, int n_in, void* d_out, int out_size, void* d_ws, size_t ws_size, hipStream_t stream) {
    static int grid = 0;
    if (grid == 0) {
        if (n_in != 20 || ws_size < WS_END) { fprintf(stderr, "kernel_launch: unexpected inputs (n_in %d, ws %zu)\n", n_in, ws_size); grid = -1; return; }
        int dev = 0, cus = 0, per_cu = 0;
        hipGetDevice(&dev); hipDeviceGetAttribute(&cus, hipDeviceAttributeMultiprocessorCount, dev);
        hipFuncSetAttribute((const void*)hybrid_fwd, hipFuncAttributeMaxDynamicSharedMemorySize, LDS_BYTES);
        hipOccupancyMaxActiveBlocksPerMultiprocessor(&per_cu, (const void*)hybrid_fwd, NTHR, LDS_BYTES);
        if (per_cu < 1) { fprintf(stderr, "kernel_launch: occupancy query says %d blocks per CU\n", per_cu); per_cu = 1; }
        grid = cus;
    }
    if (grid < 0) return;
    hipMemsetAsync((char*)d_ws + WS_CTL, 0, 1 * MiB, stream);
    Params p{};
    p.x = (const float*)d_in[0]; p.pos = (const int*)d_in[1]; p.w_in = (const float*)d_in[2]; p.mu = (const float*)d_in[3]; p.w0 = (const float*)d_in[4]; p.w_up = (const float*)d_in[5];
    p.a0 = (const float*)d_in[6]; p.a_up = (const float*)d_in[7]; p.k_k = (const float*)d_in[8]; p.k_a = (const float*)d_in[9]; p.r_k = (const float*)d_in[10]; p.gn_g = (const float*)d_in[11];
    p.gn_b = (const float*)d_in[12]; p.sinks = (const float*)d_in[13]; p.wba = (const float*)d_in[14]; p.wbb = (const float*)d_in[15]; p.wbc = (const float*)d_in[16]; p.w_out = (const float*)d_in[17];
    p.ln_g = (const float*)d_in[18]; p.ln_b = (const float*)d_in[19]; p.out = (float*)d_out; p.ws = (unsigned char*)d_ws;
    void* args[] = {&p};
    hipError_t e = hipLaunchCooperativeKernel((const void*)hybrid_fwd, dim3(grid), dim3(NTHR), args, LDS_BYTES, stream);
    if (e != hipSuccess) fprintf(stderr, "cooperative launch failed: %s (grid %d)\n", hipGetErrorString(e), grid);
}
```

```cpp
#include <hip/hip_runtime.h>
#include <hip/hip_cooperative_groups.h>
#include <cstdio>
#include <cstdint>
namespace cg = cooperative_groups;
__device__ __forceinline__ int tid_l() { int t = threadIdx.x; asm volatile("" : "+v"(t)); return t; }
namespace pg8 {
#define PG8_LAS __attribute__((address_space(3)))
typedef unsigned short bf16_t;
typedef short bf16x8 __attribute__((ext_vector_type(8)));
typedef float f32x4 __attribute__((ext_vector_type(4)));
typedef unsigned u32x4 __attribute__((ext_vector_type(4)));
constexpr int BM = 256, BK = 64, HALF = 128, HTB = HALF * BK * 2  , STAGE_BYTES = 8 * HTB, NXCD = 8, WGM = 8;

__host__ __device__ __forceinline__ int lds_byte(int r, int c) { const int st = (r >> 4) * 2 + (c >> 5), rr = r & 15, cc = c & 31, ob = rr * 64 + cc * 2; return st * 1024 + (ob ^ (((ob >> 9) & 1) << 5)); }
__host__ __device__ __forceinline__ void stage_rc(int b, int& R, int& C) { const int st = b / 1024, sb = b % 1024, swz = sb ^ (((sb >> 9) & 1) << 5); R = (st >> 1) * 16 + swz / 64; C = (st & 1) * 32 + (swz % 64) / 2; }
__host__ __device__ __forceinline__ int perm32(int rho) { const int n = rho >> 4, i = rho & 15; return 8 * (i >> 2) + 4 * n + (i & 3); }

struct Unit { int pm, pn; };
struct Gemm { const bf16_t* A; const bf16_t* Bt; int M, N, K; };

struct StaticOrder {
    int nM, nN, nwg, G, c;
    __host__ __device__ void init(int M, int N, int G_, int c_) { nM = M / BM; nN = N / BM; nwg = nM * nN; G = G_; c = c_; }
    __host__ __device__ bool next(int i, Unit& u) const {
        const long L = (long)i * G + c; if (L >= nwg) return false;
        int wgid = (int)L; { const int q = nwg / NXCD, r = nwg % NXCD, xcd = wgid % NXCD, off = wgid / NXCD; wgid = (xcd < r ? xcd * (q + 1) : r * (q + 1) + (xcd - r) * q) + off; }
        const int nig = WGM * nN, gid = wgid / nig, fm = gid * WGM, gsz = (nM - fm) < WGM ? (nM - fm) : WGM;
        u.pm = fm + ((wgid % nig) % gsz); u.pn = (wgid % nig) / gsz; return true;
    }
    __device__ __forceinline__ void a_ready(const Unit&) const {}
    __device__ __forceinline__ void done(const Unit&) const {}
};

__device__ __forceinline__ unsigned cvt_pk_bf16(float lo, float hi) { unsigned r; asm volatile("v_cvt_pk_bf16_f32 %0, %1, %2" : "=v"(r) : "v"(lo), "v"(hi)); return r; }
template <class Epi, class Sched, bool ALIGN_EPI = false, bool SP2 = false>
__device__ __forceinline__ void gemm_phase(PG8_LAS unsigned char* lds, const Gemm g, const Sched& S, const Epi& E) {
    const int tid = tid_l(), wid = __builtin_amdgcn_readfirstlane(tid >> 6), lane = tid & 63, wr = wid >> 2, wc = wid & 3, fr = lane & 15, fq = lane >> 4;
    const int K = g.K, nt = K / BK;
    unsigned voffA[2], voffB[2];
#pragma unroll
    for (int i = 0; i < 2; ++i) { int R, C; stage_rc(tid * 16 + i * 8192, R, C); const int Rb = Epi::PERM ? ((R & ~31) + perm32(R & 31)) : R;
        voffA[i] = (unsigned)(R * K + C) * 2u; voffB[i] = (unsigned)(Rb * K + C) * 2u; }
    const size_t kstep = (size_t)(BK * 2);
    const size_t hstep = (size_t)HALF * K * 2;
    const size_t tstep = 2 * hstep;
    const unsigned ldsw = (unsigned)wid * 1024u;
    const int aoff = lds_byte(wr * 64 + fr, fq * 8), boff = lds_byte(wc * 32 + fr, fq * 8);
#define PG8_SA(b, h) (((b) * 2 + (h)) * HTB)
#define PG8_SB(b, h) ((4 + (b) * 2 + (h)) * HTB)
#define PG8_STAGE(bufoff, gbase, voff) do { _Pragma("unroll") for (int _i = 0; _i < 2; ++_i) \
        __builtin_amdgcn_global_load_lds((const unsigned*)((const char*)(gbase) + (voff)[_i]), (PG8_LAS unsigned*)(lds + (bufoff) + ldsw + _i * 8192), 16, 0, 0); } while (0)
#define PG8_LDA(dst, b, h) do { _Pragma("unroll") for (int m = 0; m < 4; ++m) _Pragma("unroll") for (int k = 0; k < 2; ++k) dst[m][k] = *(const PG8_LAS bf16x8*)(lds + PG8_SA(b, h) + aoff + m * 2048 + k * 1024); } while (0)
#define PG8_LDB(dst, b, h) do { _Pragma("unroll") for (int n = 0; n < 2; ++n) _Pragma("unroll") for (int k = 0; k < 2; ++k) dst[n][k] = *(const PG8_LAS bf16x8*)(lds + PG8_SB(b, h) + boff + n * 2048 + k * 1024); } while (0)
#define PG8_MMA(ai, bj, At, Bt) do { __builtin_amdgcn_s_setprio(1); _Pragma("unroll") for (int m = 0; m < 4; ++m) _Pragma("unroll") for (int n = 0; n < 2; ++n) _Pragma("unroll") for (int k = 0; k < 2; ++k) \
        acc[ai][bj][m][n] = __builtin_amdgcn_mfma_f32_16x16x32_bf16(Bt[n][k], At[m][k], acc[ai][bj][m][n], 0, 0, 0); __builtin_amdgcn_s_setprio(0); } while (0)
#define PG8_WAIT_V(n) asm volatile("s_waitcnt vmcnt(" #n ")" ::: "memory")
#define PG8_WAIT_L(n) asm volatile("s_waitcnt lgkmcnt(" #n ")" ::: "memory")
#define PG8_BAR __builtin_amdgcn_s_barrier()
#define PG8_SCHED __builtin_amdgcn_sched_barrier(0)
    Unit cur, nxt; int ui = 0;
    if (!S.next(0, cur)) return;
    f32x4 acc[2][2][4][2];
#pragma unroll
    for (int a = 0; a < 2; ++a)
#pragma unroll
        for (int b = 0; b < 2; ++b)
#pragma unroll
            for (int m = 0; m < 4; ++m)
#pragma unroll
                for (int n = 0; n < 2; ++n) acc[a][b][m][n] = (f32x4){0.f, 0.f, 0.f, 0.f};
    bf16x8 At[4][2], B0[2][2], B1[2][2];
    const char* cA = (const char*)g.A + (size_t)cur.pm * tstep; const char* cB = (const char*)g.Bt + (size_t)cur.pn * tstep;
    S.a_ready(cur);
    if constexpr (SP2) {
        PG8_STAGE(PG8_SB(0, 0), cB, voffB); PG8_STAGE(PG8_SB(0, 1), cB + hstep, voffB); PG8_STAGE(PG8_SA(0, 0), cA, voffA); PG8_STAGE(PG8_SA(0, 1), cA + hstep, voffA);
        if (wr == 1) PG8_BAR;
        PG8_WAIT_V(2); PG8_BAR;
        PG8_STAGE(PG8_SB(1, 0), cB + kstep, voffB); PG8_STAGE(PG8_SA(1, 0), cA + kstep, voffA); PG8_STAGE(PG8_SB(1, 1), cB + hstep + kstep, voffB);
        PG8_WAIT_V(6); PG8_BAR;
    } else {
        PG8_STAGE(PG8_SB(0, 0), cB, voffB); PG8_STAGE(PG8_SA(0, 0), cA, voffA); PG8_STAGE(PG8_SB(0, 1), cB + hstep, voffB); PG8_STAGE(PG8_SA(0, 1), cA + hstep, voffA);
        if (wr == 1) PG8_BAR;
        PG8_WAIT_V(4); PG8_BAR;
        PG8_STAGE(PG8_SB(1, 0), cB + kstep, voffB); PG8_STAGE(PG8_SA(1, 0), cA + kstep, voffA); PG8_STAGE(PG8_SB(1, 1), cB + hstep + kstep, voffB);
        PG8_WAIT_V(6); PG8_BAR;
    }
    for (;;) {
        const bool has_next = S.next(ui + 1, nxt);
        const char* nA = has_next ? (const char*)g.A + (size_t)nxt.pm * tstep : cA; const char* nB = has_next ? (const char*)g.Bt + (size_t)nxt.pn * tstep : cB;
        for (int t = 0; t < nt; t += 2) {
            const bool last = (t == nt - 2);
            const char* a1 = cA + (size_t)(t + 1) * kstep;
            const char* a2 = last ? nA : cA + (size_t)(t + 2) * kstep; const char* b2 = last ? nB : cB + (size_t)(t + 2) * kstep;
            const char* a3 = a2 + kstep; const char* b3 = b2 + kstep;
            if (last && has_next) S.a_ready(nxt);
            if constexpr (SP2) {
            PG8_LDB(B0, 0, 0); PG8_LDB(B1, 0, 1); PG8_SCHED; PG8_LDA(At, 0, 0); PG8_STAGE(PG8_SA(1, 1), a1 + hstep, voffA);
            PG8_WAIT_V(8); PG8_WAIT_L(0); PG8_BAR; PG8_MMA(0, 0, At, B0); PG8_MMA(0, 1, At, B1); PG8_BAR; PG8_SCHED;
            PG8_LDA(At, 0, 1); PG8_STAGE(PG8_SB(0, 0), b2, voffB); PG8_STAGE(PG8_SB(0, 1), b2 + hstep, voffB); PG8_STAGE(PG8_SA(0, 0), a2, voffA);
            PG8_WAIT_V(8); PG8_WAIT_L(0); PG8_BAR; PG8_MMA(1, 0, At, B0); PG8_MMA(1, 1, At, B1); PG8_BAR; PG8_SCHED;
            PG8_LDB(B0, 1, 0); PG8_LDB(B1, 1, 1); PG8_SCHED; PG8_LDA(At, 1, 0); PG8_STAGE(PG8_SA(0, 1), a2 + hstep, voffA);
            PG8_WAIT_V(8); PG8_WAIT_L(0); PG8_BAR; PG8_MMA(0, 0, At, B0); PG8_MMA(0, 1, At, B1); PG8_BAR; PG8_SCHED;
            PG8_LDA(At, 1, 1); PG8_STAGE(PG8_SB(1, 0), b3, voffB); PG8_STAGE(PG8_SB(1, 1), b3 + hstep, voffB); PG8_STAGE(PG8_SA(1, 0), a3, voffA);
            PG8_WAIT_V(8); PG8_WAIT_L(0); PG8_BAR; PG8_MMA(1, 0, At, B0); PG8_MMA(1, 1, At, B1); PG8_BAR; PG8_SCHED;
            } else {
            PG8_LDB(B0, 0, 0); PG8_SCHED; PG8_LDA(At, 0, 0); PG8_STAGE(PG8_SA(1, 1), a1 + hstep, voffA);
            PG8_WAIT_L(8); PG8_BAR; PG8_WAIT_L(0); PG8_MMA(0, 0, At, B0); PG8_BAR; PG8_SCHED;
            PG8_LDB(B1, 0, 1); PG8_STAGE(PG8_SB(0, 0), b2, voffB);
            PG8_BAR; PG8_WAIT_L(0); PG8_MMA(0, 1, At, B1); PG8_BAR;
            PG8_LDA(At, 0, 1); PG8_STAGE(PG8_SA(0, 0), a2, voffA);
            PG8_BAR; PG8_WAIT_L(0); PG8_MMA(1, 0, At, B0); PG8_BAR; PG8_SCHED;
            PG8_STAGE(PG8_SB(0, 1), b2 + hstep, voffB);
            PG8_WAIT_V(6); PG8_BAR; PG8_MMA(1, 1, At, B1); PG8_BAR;
            PG8_LDB(B0, 1, 0); PG8_SCHED; PG8_LDA(At, 1, 0); PG8_STAGE(PG8_SA(0, 1), a2 + hstep, voffA);
            PG8_WAIT_L(8); PG8_BAR; PG8_WAIT_L(0); PG8_MMA(0, 0, At, B0); PG8_BAR; PG8_SCHED;
            PG8_LDB(B1, 1, 1); PG8_STAGE(PG8_SB(1, 0), b3, voffB);
            PG8_BAR; PG8_WAIT_L(0); PG8_MMA(0, 1, At, B1); PG8_BAR;
            PG8_LDA(At, 1, 1); PG8_STAGE(PG8_SA(1, 0), a3, voffA);
            PG8_BAR; PG8_WAIT_L(0); PG8_MMA(1, 0, At, B0); PG8_BAR; PG8_SCHED;
            PG8_STAGE(PG8_SB(1, 1), b3 + hstep, voffB);
            PG8_WAIT_V(6); PG8_BAR; PG8_MMA(1, 1, At, B1); PG8_BAR;
            }
        }
        if constexpr (ALIGN_EPI) { if (wr == 0) PG8_BAR; }
        if constexpr (!Epi::AFTER_DRAIN) { E(acc, cur, wr, wc, fr, fq); S.done(cur); }
        if (!has_next) break;
#pragma unroll
        for (int a = 0; a < 2; ++a)
#pragma unroll
            for (int b = 0; b < 2; ++b)
#pragma unroll
                for (int m = 0; m < 4; ++m)
#pragma unroll
                    for (int n = 0; n < 2; ++n) acc[a][b][m][n] = (f32x4){0.f, 0.f, 0.f, 0.f};
        cur = nxt; cA = nA; cB = nB; ++ui;
        if constexpr (ALIGN_EPI) { if (wr == 1) PG8_BAR; }
    }
    PG8_WAIT_V(0);
    if constexpr (!ALIGN_EPI) { if (wr == 0) PG8_BAR; }
    PG8_BAR;
    if constexpr (Epi::AFTER_DRAIN) { E.fused(acc, cur, wr, wc, fr, fq, lds, wid, lane); S.done(cur); }
#undef PG8_SA
#undef PG8_SB
#undef PG8_STAGE
#undef PG8_LDA
#undef PG8_LDB
#undef PG8_MMA
#undef PG8_WAIT_V
#undef PG8_WAIT_L
#undef PG8_BAR
#undef PG8_SCHED
}
}

#define LAS __attribute__((address_space(3)))
using pg8::bf16_t; using pg8::bf16x8; using pg8::f32x4; using pg8::Unit;
typedef float f32x16 __attribute__((ext_vector_type(16)));
typedef unsigned u32x4 __attribute__((ext_vector_type(4)));
typedef unsigned u32x2 __attribute__((ext_vector_type(2)));

constexpr int MTOK = 16384, SEQL = 8192, DM = 1024, INW = 8576, NLAYER = 2;
constexpr float C2F = 0.125f * 1.4426950408889634f;
constexpr float LOG2E = 1.4426950408889634f;
constexpr float NEGF = -1.0e30f;
constexpr float ALPHA_RES = 1.4142135623730951f;
constexpr int NTHR = 512;
#ifndef PHMASK
#define PHMASK 0x1ff
#endif
constexpr int LDS_BYTES = 147456;

constexpr size_t MiB = 1u << 20;
constexpr size_t WS_CTL = 0;
constexpr size_t WS_COS = 1 * MiB;
constexpr size_t WS_SIN = 3 * MiB;
constexpr size_t WS_KMEAN = 5 * MiB;
constexpr size_t WS_RK = 5 * MiB + 256 * 1024;
constexpr size_t WS_BND = 6 * MiB;
constexpr size_t WS_XB = 7 * MiB;
constexpr size_t WS_WIN = 39 * MiB;
constexpr size_t WS_WBR = 56 * MiB;
constexpr size_t WS_WOUT = 59 * MiB;
constexpr size_t WS_QA = 61 * MiB;
constexpr size_t WS_KA = 77 * MiB;
constexpr size_t WS_VA = 93 * MiB;
constexpr size_t WS_RB = 109 * MiB;
constexpr size_t WS_KB = 125 * MiB;
constexpr size_t WS_VB = 141 * MiB;
constexpr size_t WS_MISC = 157 * MiB;
constexpr size_t WS_OB = 173 * MiB;
constexpr size_t WS_QC = 189 * MiB;
constexpr size_t WS_DW = 205 * MiB;
constexpr size_t WS_KK = 221 * MiB;
constexpr size_t WS_BB = 237 * MiB;
constexpr size_t WS_END = 253 * MiB;
constexpr size_t WS_Y = WS_KA;
constexpr size_t WS_MERGED = WS_RB;

__device__ __forceinline__ float bflo(unsigned u) { return __uint_as_float(u << 16); }
__device__ __forceinline__ float bfhi(unsigned u) { return __uint_as_float(u & 0xffff0000u); }
__device__ __forceinline__ unsigned pk2(float lo, float hi) { return pg8::cvt_pk_bf16(lo, hi); }
__device__ __forceinline__ float sigmoidf_(float x) { return 1.0f / (1.0f + __expf(-x)); }
__device__ __forceinline__ int crow(int r, int hi) { return (r & 3) + 8 * (r >> 2) + 4 * hi; }
#define LDS_WAIT() asm volatile("s_waitcnt lgkmcnt(0)" ::: "memory")

struct Params;
__device__ __forceinline__ unsigned char* wsl(const Params& P);
struct Params {
    const float* x; const int* pos; const float* w_in; const float* mu; const float* w0; const float* w_up; const float* a0; const float* a_up;
    const float* k_k; const float* k_a; const float* r_k; const float* gn_g; const float* gn_b; const float* sinks;
    const float* wba; const float* wbb; const float* wbc; const float* w_out; const float* ln_g; const float* ln_b;
    float* out; unsigned char* ws;
};

__device__ __forceinline__ unsigned char* wsl(const Params& P) { unsigned char* w = P.ws; asm volatile("" : "+s"(w)); return w; }

struct Epi1 {
    static constexpr bool PERM = false, AFTER_DRAIN = false;
    unsigned char* ws;
    __device__ __forceinline__ void operator()(const f32x4 (&acc)[2][2][4][2], const Unit& u, int wr, int wc, int fr, int fq) const {
        const int pn = u.pn; const int row0 = u.pm * 256 + wr * 64 + fr;
        const float* cosT = (const float*)(ws + WS_COS); const float* sinT = (const float*)(ws + WS_SIN); float* KMEAN = (float*)(ws + WS_KMEAN); bf16_t* BND = (bf16_t*)(ws + WS_BND);
#pragma unroll
        for (int bj = 0; bj < 2; ++bj) {
            int kind = 0; size_t doff = 0; constexpr int pitch = 512; int cb = 0; float sc = 1.f; int bcol = -1; const int tcol = 128 * bj;
            if (pn < 12) { doff = WS_QA + (size_t)(pn >> 1) * (16 * MiB); cb = (pn & 1) * 256 + tcol; kind = pn < 4 ? 1 : 0; if (pn < 2) sc = C2F; if (pn >= 6) bcol = ((pn - 6) >> 1) * 512 + cb; }
            else if (pn == 12) { if (bj == 0) { doff = WS_MISC; cb = 256; bcol = 1536; } else kind = 2; }
            else if (pn < 15) { kind = 1; doff = WS_QC; cb = (pn - 13) * 256 + tcol; sc = C2F; }
            else { doff = WS_MISC; if (bj == 0) { kind = 1; cb = 0; } else { cb = 128; } }
            bf16_t* dst = (bf16_t*)(ws + doff);
            if (kind == 2) continue;
            if (kind == 0) {
#pragma unroll
                for (int ai = 0; ai < 2; ++ai)
#pragma unroll
                    for (int m = 0; m < 4; ++m) { const int row = row0 + ai * 128 + m * 16;
#pragma unroll
                        for (int n = 0; n < 2; ++n) { const f32x4 v = acc[ai][bj][m][n]; u32x2 w; w.x = pk2(v[0], v[1]); w.y = pk2(v[2], v[3]);
                            const int c = 32 * wc + 16 * n + 4 * fq;
                            *(u32x2*)(dst + (unsigned)(row * pitch + cb + c)) = w;
                            if (bcol >= 0 && m == 3 && fr == 15) *(u32x2*)(BND + (unsigned)((row >> 6) * 1664 + bcol + c)) = w; }
                        asm volatile("" ::: "memory"); }
            } else {
                const int f0 = 16 * (wc & 1) + 4 * fq; const int c1 = cb + 64 * (wc >> 1) + f0;
                const bool km = (pn == 2 || pn == 3);
                f32x4 s1 = {0.f, 0.f, 0.f, 0.f}, s2 = {0.f, 0.f, 0.f, 0.f};
#pragma unroll
                for (int ai = 0; ai < 2; ++ai)
#pragma unroll
                    for (int m = 0; m < 4; ++m) { const int row = row0 + ai * 128 + m * 16;
                        const f32x4 cs = *(const f32x4*)(cosT + (unsigned)(row * 32 + f0)), sn = *(const f32x4*)(sinT + (unsigned)(row * 32 + f0));
                        const f32x4 x1 = acc[ai][bj][m][0], x2 = acc[ai][bj][m][1];
                        const f32x4 o1 = x1 * cs - x2 * sn, o2 = x2 * cs + x1 * sn;
                        s1 += o1; s2 += o2;
                        u32x2 w; w.x = pk2(o1[0] * sc, o1[1] * sc); w.y = pk2(o1[2] * sc, o1[3] * sc);
                        *(u32x2*)(dst + (unsigned)(row * pitch + c1)) = w;
                        w.x = pk2(o2[0] * sc, o2[1] * sc); w.y = pk2(o2[2] * sc, o2[3] * sc);
                        *(u32x2*)(dst + (unsigned)(row * pitch + c1 + 32)) = w;
                        asm volatile("" ::: "memory"); }
                if (km) {
#pragma unroll
                    for (int j = 0; j < 4; ++j) {
                        float a = s1[j], b = s2[j];
#pragma unroll
                        for (int o = 1; o < 16; o <<= 1) { a += __shfl_xor(a, o); b += __shfl_xor(b, o); }
                        if (fr == 0) { atomicAdd(KMEAN + (unsigned)(u.pm * 512 + c1 + j), a); atomicAdd(KMEAN + (unsigned)(u.pm * 512 + c1 + 32 + j), b); }
                    }
                }
            }
        }
    }
};

struct EpiZ {
    static constexpr bool PERM = false, AFTER_DRAIN = false;
    unsigned char* ws;
    __device__ __forceinline__ void operator()(const f32x4 (&acc)[2][2][4][2], const Unit& u, int wr, int wc, int fr, int fq) const {
        const int br = u.pn >> 1; bf16_t* O = (bf16_t*)(ws + (br == 0 ? WS_QA : (br == 1 ? WS_DW : WS_QC)));
        const int row0 = u.pm * 256 + wr * 64 + fr; const int cb = (u.pn & 1) * 256 + 32 * wc + 4 * fq;
#pragma unroll
        for (int ai = 0; ai < 2; ++ai)
#pragma unroll
            for (int m = 0; m < 4; ++m) { const int row = row0 + ai * 128 + m * 16;
#pragma unroll
                for (int bj = 0; bj < 2; ++bj)
#pragma unroll
                    for (int n = 0; n < 2; ++n) { const f32x4 z = acc[ai][bj][m][n]; u32x2* p = (u32x2*)(O + (unsigned)(row * 512 + cb + 128 * bj + 16 * n));
                        u32x2 w;
                        if (br == 1) { w.x = pk2(z[0], z[1]); w.y = pk2(z[2], z[3]); }
                        else { const u32x2 o = *p;
                            w.x = pk2(bflo(o.x) * z[0] * sigmoidf_(z[0]), bfhi(o.x) * z[1] * sigmoidf_(z[1]));
                            w.y = pk2(bflo(o.y) * z[2] * sigmoidf_(z[2]), bfhi(o.y) * z[3] * sigmoidf_(z[3])); }
                        *p = w; }
                asm volatile("" ::: "memory"); }
    }
};

struct EpiY {
    static constexpr bool PERM = false, AFTER_DRAIN = false;
    bf16_t* Y;
    __device__ __forceinline__ void operator()(const f32x4 (&acc)[2][2][4][2], const Unit& u, int wr, int wc, int fr, int fq) const {
        const int row0 = u.pm * 256 + wr * 64 + fr; const int cb = u.pn * 256 + 32 * wc + 4 * fq;
#pragma unroll
        for (int ai = 0; ai < 2; ++ai)
#pragma unroll
            for (int m = 0; m < 4; ++m) { const int row = row0 + ai * 128 + m * 16;
#pragma unroll
                for (int bj = 0; bj < 2; ++bj)
#pragma unroll
                    for (int n = 0; n < 2; ++n) { const f32x4 v = acc[ai][bj][m][n]; u32x2 w; w.x = pk2(v[0], v[1]); w.y = pk2(v[2], v[3]);
                        *(u32x2*)(Y + (unsigned)(row * 1024 + cb + 128 * bj + 16 * n)) = w; } }
    }
};

struct EpiG {
    static constexpr bool PERM = false, AFTER_DRAIN = false;
    const bf16_t* Y; bf16_t* MG; int first;
    __device__ __forceinline__ void operator()(const f32x4 (&acc)[2][2][4][2], const Unit& u, int wr, int wc, int fr, int fq) const {
        const int row0 = u.pm * 256 + wr * 64 + fr; const int cb = u.pn * 256 + 32 * wc + 4 * fq;
#pragma unroll
        for (int ai = 0; ai < 2; ++ai)
#pragma unroll
            for (int m = 0; m < 4; ++m) { const int row = row0 + ai * 128 + m * 16;
#pragma unroll
                for (int bj = 0; bj < 2; ++bj)
#pragma unroll
                    for (int n = 0; n < 2; ++n) { const f32x4 g = acc[ai][bj][m][n]; const unsigned off = (unsigned)(row * 1024 + cb + 128 * bj + 16 * n);
                        const u32x2 y = *(const u32x2*)(Y + off); u32x2 mg = {0u, 0u}; if (!first) mg = *(const u32x2*)(MG + off);
                        u32x2 w;
                        w.x = pk2(bflo(mg.x) + sigmoidf_(g[0]) * bflo(y.x), bfhi(mg.x) + sigmoidf_(g[1]) * bfhi(y.x));
                        w.y = pk2(bflo(mg.y) + sigmoidf_(g[2]) * bflo(y.y), bfhi(mg.y) + sigmoidf_(g[3]) * bfhi(y.y));
                        *(u32x2*)(MG + off) = w; }
                asm volatile("" ::: "memory"); }
    }
};

struct EpiOut {
    static constexpr bool PERM = false, AFTER_DRAIN = false;
    const float* xres; float* out;
    __device__ __forceinline__ void operator()(const f32x4 (&acc)[2][2][4][2], const Unit& u, int wr, int wc, int fr, int fq) const {
        const int row0 = u.pm * 256 + wr * 64 + fr; const int cb = u.pn * 256 + 32 * wc + 4 * fq;
#pragma unroll
        for (int ai = 0; ai < 2; ++ai)
#pragma unroll
            for (int m = 0; m < 4; ++m) { const int row = row0 + ai * 128 + m * 16;
#pragma unroll
                for (int bj = 0; bj < 2; ++bj)
#pragma unroll
                    for (int n = 0; n < 2; ++n) { const unsigned off = (unsigned)(row * 1024 + cb + 128 * bj + 16 * n);
                        const f32x4 xr = *(const f32x4*)(xres + off); *(f32x4*)(out + off) = xr * ALPHA_RES + acc[ai][bj][m][n]; }
                asm volatile("" ::: "memory"); }
    }
};

struct EpiAll {
    static constexpr bool PERM = false, AFTER_DRAIN = false;
    Epi1 e1; EpiZ ez; EpiY ey; EpiG eg; EpiOut eo; int mode;
    __device__ __forceinline__ void operator()(const f32x4 (&acc)[2][2][4][2], const Unit& u, int wr, int wc, int fr, int fq) const {
        if (mode == 0) e1(acc, u, wr, wc, fr, fq);
        else if (mode == 1) ez(acc, u, wr, wc, fr, fq);
        else if (mode == 2) ey(acc, u, wr, wc, fr, fq);
        else if (mode == 3) eg(acc, u, wr, wc, fr, fq);
        else eo(acc, u, wr, wc, fr, fq);
    }
};

__device__ __forceinline__ int rope_perm(int q) { const int hd = q >> 6, r = q & 63; return hd * 64 + 16 * (r >> 5) + (r & 15) + 32 * ((r >> 4) & 1); }
__device__ __forceinline__ int win_map(int p) {
    if (p < 4096) {
        const int t = p >> 8, q = p & 255;
        if (t < 2) return t * 256 + rope_perm(q);
        if (t < 4) return 512 + (t - 2) * 256 + rope_perm(q);
        if (t < 6) return 1024 + (t - 4) * 256 + q;
        if (t < 8) return 2048 + (t - 6) * 256 + q;
        if (t < 10) return 2560 + (t - 8) * 256 + q;
        if (t < 12) return 3072 + (t - 10) * 256 + q;
        if (t == 12) return q < 128 ? 3584 + q : -1;
        if (t < 15) return 4224 + (t - 13) * 256 + rope_perm(q);
        return q < 128 ? 4736 + rope_perm(q) : 4864 + (q - 128);
    }
    if (p < 5632) { const int q = p - 4096, br = q >> 9, c = q & 511; return br == 0 ? 1536 + c : (br == 1 ? 3712 + c : 4992 + c); }
    return 5504 + (p - 5632);
}
__device__ __forceinline__ void transpose_item(const float* W, int Nsrc, bf16_t* WT, int K, int k0, int p0, int srccol, LAS float* scr, int lane) {
#pragma unroll 8
    for (int i = 0; i < 32; ++i) { const int kk = 2 * i + (lane >> 5); scr[kk * 33 + (lane & 31)] = srccol >= 0 ? W[(size_t)(k0 + kk) * Nsrc + srccol] : 0.f; }
    LDS_WAIT();
    const int c = lane & 7;
#pragma unroll
    for (int j = 0; j < 4; ++j) { const int n = (lane >> 3) + 8 * j; const LAS float* s = scr + (8 * c) * 33 + n;
        u32x4 o; o.x = pk2(s[0 * 33], s[1 * 33]); o.y = pk2(s[2 * 33], s[3 * 33]); o.z = pk2(s[4 * 33], s[5 * 33]); o.w = pk2(s[6 * 33], s[7 * 33]);
        *(u32x4*)(WT + (size_t)(p0 + n) * K + k0 + 8 * c) = o; }
    LDS_WAIT();
}
__device__ __forceinline__ float wave_sum(float v) {
#pragma unroll
    for (int o = 1; o < 64; o <<= 1) v += __shfl_xor(v, o);
    return v;
}
__device__ __forceinline__ void row_to_bf16(const float* src, float* dst_f32, bf16_t* dst_bf, const float* g, const float* b, bool do_ln, int lane) {
    const f32x4* xr = (const f32x4*)src + lane;
    f32x4 v[4]; float s = 0.f;
#pragma unroll
    for (int j = 0; j < 4; ++j) { v[j] = xr[64 * j]; s += (v[j][0] + v[j][1]) + (v[j][2] + v[j][3]); }
    if (do_ln) {
        const float mean = wave_sum(s) * (1.f / 1024.f); float s2 = 0.f;
#pragma unroll
        for (int j = 0; j < 4; ++j) { v[j] = v[j] - mean; s2 += (v[j][0] * v[j][0] + v[j][1] * v[j][1]) + (v[j][2] * v[j][2] + v[j][3] * v[j][3]); }
        const float rstd = 1.0f / sqrtf(wave_sum(s2) * (1.f / 1024.f) + 1e-5f);
#pragma unroll
        for (int j = 0; j < 4; ++j) { const f32x4 gg = ((const f32x4*)g)[lane + 64 * j], bb = ((const f32x4*)b)[lane + 64 * j]; v[j] = v[j] * rstd * gg + bb; }
        if (dst_f32) {
#pragma unroll
            for (int j = 0; j < 4; ++j) ((f32x4*)dst_f32)[lane + 64 * j] = v[j];
        }
    }
    if (dst_bf) {
#pragma unroll
        for (int j = 0; j < 4; ++j) { u32x2 w; w.x = pk2(v[j][0], v[j][1]); w.y = pk2(v[j][2], v[j][3]); ((u32x2*)dst_bf)[lane + 64 * j] = w; }
    }
}

constexpr int KS_PITCH = 144, VT_PITCH = 80, VT_TILE = 64 * 80;
constexpr int ALDS_K = 0, ALDS_V = 55296, ALDS_KM = 116736, ALDS_SEL = 124672;

template <class MaskF>
__device__ __forceinline__ void attn_tile(const LAS unsigned char* Kt, const LAS unsigned char* Vt, const bf16x8 (&qf)[4], float& m, float& l, f32x16& o0, f32x16& o1,
                                          int r32, int hi, bool masked, MaskF valid) {
    f32x16 s;
#pragma unroll
    for (int r = 0; r < 16; ++r) s[r] = 0.f;
#pragma unroll
    for (int ks = 0; ks < 4; ++ks) { const bf16x8 a = *(const LAS bf16x8*)(Kt + r32 * KS_PITCH + (ks * 16 + hi * 8) * 2); s = __builtin_amdgcn_mfma_f32_32x32x16_bf16(a, qf[ks], s, 0, 0, 0); }
    if (masked) {
#pragma unroll
        for (int r = 0; r < 16; ++r) if (!valid(crow(r, hi))) s[r] = NEGF;
    }
    float mx = s[0];
#pragma unroll
    for (int r = 1; r < 16; ++r) mx = fmaxf(mx, s[r]);
    mx = fmaxf(mx, __shfl_xor(mx, 32));
    const float mn = fmaxf(m, mx); const float alpha = __builtin_amdgcn_exp2f(m - mn); m = mn;
    float ps = 0.f;
#pragma unroll
    for (int r = 0; r < 16; ++r) { s[r] = __builtin_amdgcn_exp2f(s[r] - mn); ps += s[r]; }
    l = l * alpha + ps;
#pragma unroll
    for (int r = 0; r < 16; ++r) { o0[r] *= alpha; o1[r] *= alpha; }
#pragma unroll
    for (int s2 = 0; s2 < 2; ++s2) {
        u32x4 pw; pw.x = pk2(s[8 * s2 + 0], s[8 * s2 + 1]); pw.y = pk2(s[8 * s2 + 2], s[8 * s2 + 3]); pw.z = pk2(s[8 * s2 + 4], s[8 * s2 + 5]); pw.w = pk2(s[8 * s2 + 6], s[8 * s2 + 7]);
        const bf16x8 pb = __builtin_bit_cast(bf16x8, pw);
        { const LAS unsigned char* vp = Vt + r32 * VT_PITCH + (16 * s2 + 4 * hi) * 2; const u32x2 lo = *(const LAS u32x2*)vp, hh = *(const LAS u32x2*)(vp + 16);
          u32x4 aw; aw.x = lo.x; aw.y = lo.y; aw.z = hh.x; aw.w = hh.y; o0 = __builtin_amdgcn_mfma_f32_32x32x16_bf16(__builtin_bit_cast(bf16x8, aw), pb, o0, 0, 0, 0); }
        { const LAS unsigned char* vp = Vt + (32 + r32) * VT_PITCH + (16 * s2 + 4 * hi) * 2; const u32x2 lo = *(const LAS u32x2*)vp, hh = *(const LAS u32x2*)(vp + 16);
          u32x4 aw; aw.x = lo.x; aw.y = lo.y; aw.z = hh.x; aw.w = hh.y; o1 = __builtin_amdgcn_mfma_f32_32x32x16_bf16(__builtin_bit_cast(bf16x8, aw), pb, o1, 0, 0, 0); }
    }
}
__device__ __forceinline__ void stage_kv(LAS unsigned char* lds, const bf16_t* Ksrc, const bf16_t* Vsrc, int pitch, int nkeys, int first_valid, int tid) {
    for (int i = tid; i < nkeys * 8; i += NTHR) {
        const int key = i >> 3, pc = i & 7;
        if (key < first_valid) continue;
        const u32x4 kv = *(const u32x4*)(Ksrc + (size_t)key * pitch + pc * 8);
        *(LAS u32x4*)(lds + ALDS_K + key * KS_PITCH + pc * 16) = kv;
    }
    for (int i = tid; i < nkeys * 8; i += NTHR) {
        const int key = i % nkeys, pc = i / nkeys;
        if (key < first_valid) continue;
        const u32x4 vv = *(const u32x4*)(Vsrc + (size_t)key * pitch + pc * 8);
        LAS unsigned short* vt = (LAS unsigned short*)(lds + ALDS_V + (key >> 5) * VT_TILE + (pc * 8) * VT_PITCH + (key & 31) * 2);
        vt[0 * 40] = (unsigned short)(vv.x & 0xffffu); vt[1 * 40] = (unsigned short)(vv.x >> 16);
        vt[2 * 40] = (unsigned short)(vv.y & 0xffffu); vt[3 * 40] = (unsigned short)(vv.y >> 16);
        vt[4 * 40] = (unsigned short)(vv.z & 0xffffu); vt[5 * 40] = (unsigned short)(vv.z >> 16);
        vt[6 * 40] = (unsigned short)(vv.w & 0xffffu); vt[7 * 40] = (unsigned short)(vv.w >> 16);
    }
}
__device__ __forceinline__ void attn_store(bf16_t* O, int pitch, const f32x16& o0, const f32x16& o1, float inv, int hi) {
#pragma unroll
    for (int g = 0; g < 4; ++g) {
        u32x2 w; w.x = pk2(o0[4 * g] * inv, o0[4 * g + 1] * inv); w.y = pk2(o0[4 * g + 2] * inv, o0[4 * g + 3] * inv);
        *(u32x2*)(O + 8 * g + 4 * hi) = w;
        w.x = pk2(o1[4 * g] * inv, o1[4 * g + 1] * inv); w.y = pk2(o1[4 * g + 2] * inv, o1[4 * g + 3] * inv);
        *(u32x2*)(O + 32 + 8 * g + 4 * hi) = w;
    }
}

__device__ __forceinline__ void moba_item(unsigned char* ldsg, LAS unsigned char* lds, const Params& P, int b, int h, int n) {
    const int tid = tid_l(), lane = tid & 63, r32 = lane & 31, hi = lane >> 5; const int w = __builtin_amdgcn_readfirstlane(tid >> 6);
    bf16_t* QA = (bf16_t*)(wsl(P) + WS_QA); const bf16_t* KA = (const bf16_t*)(wsl(P) + WS_KA); const bf16_t* VA = (const bf16_t*)(wsl(P) + WS_VA);
    const float* KMEAN = (const float*)(wsl(P) + WS_KMEAN);
    const size_t rowbase = (size_t)b * SEQL + (size_t)n * 256;
    LAS float* KM = (LAS float*)(lds + ALDS_KM); LAS int* SEL = (LAS int*)(lds + ALDS_SEL);
    __syncthreads();
    for (int i = tid; i < n * 64; i += NTHR) KM[i] = KMEAN[(size_t)(b * 32 + (i >> 6)) * 512 + h * 64 + (i & 63)];
    __syncthreads();
    if (tid < 256) {
        int mask = 0;
        if (n <= 3) mask = (1 << n) - 1;
        else {
            float q[64];
            const u32x4* qp = (const u32x4*)(QA + (rowbase + tid) * 512 + h * 64);
#pragma unroll
            for (int i = 0; i < 8; ++i) { const u32x4 t = qp[i]; q[8 * i] = bflo(t.x); q[8 * i + 1] = bfhi(t.x); q[8 * i + 2] = bflo(t.y); q[8 * i + 3] = bfhi(t.y); q[8 * i + 4] = bflo(t.z); q[8 * i + 5] = bfhi(t.z); q[8 * i + 6] = bflo(t.w); q[8 * i + 7] = bfhi(t.w); }
            float v1 = -3.0e38f, v2 = -3.0e38f, v3 = -3.0e38f; int i1 = 0, i2 = 0, i3 = 0;
            for (int j = 0; j < n; ++j) {
                float g0 = 0.f, g1 = 0.f, g2 = 0.f, g3 = 0.f;
#pragma unroll
                for (int d = 0; d < 64; d += 4) { const f32x4 kmv = *(const LAS f32x4*)(KM + j * 64 + d); g0 += q[d] * kmv[0]; g1 += q[d + 1] * kmv[1]; g2 += q[d + 2] * kmv[2]; g3 += q[d + 3] * kmv[3]; }
                const float g = (g0 + g1) + (g2 + g3);
                if (g > v1) { v3 = v2; i3 = i2; v2 = v1; i2 = i1; v1 = g; i1 = j; }
                else if (g > v2) { v3 = v2; i3 = i2; v2 = g; i2 = j; }
                else if (g > v3) { v3 = g; i3 = j; }
            }
            mask = (1 << i1) | (1 << i2) | (1 << i3);
        }
        SEL[tid] = mask;
    }
    __syncthreads();
    const int sel = SEL[w * 32 + r32];
    bf16x8 qf[4];
    { const bf16_t* qrow = QA + (rowbase + w * 32 + r32) * 512 + h * 64;
#pragma unroll
      for (int ks = 0; ks < 4; ++ks) qf[ks] = *(const bf16x8*)(qrow + ks * 16 + hi * 8); }
    float m = NEGF, l = 0.f; f32x16 o0, o1;
#pragma unroll
    for (int r = 0; r < 16; ++r) { o0[r] = 0.f; o1[r] = 0.f; }
    for (int j = 0; j <= n; ++j) {
        __syncthreads();
        stage_kv(lds, KA + ((size_t)b * SEQL + (size_t)j * 256) * 512 + h * 64, VA + ((size_t)b * SEQL + (size_t)j * 256) * 512 + h * 64, 512, 256, 0, tid);
        __syncthreads();
        if (j < n) {
            const bool mine = (sel >> j) & 1;
            if (__any(mine)) {
                for (int t = 0; t < 8; ++t)
                    attn_tile(lds + ALDS_K + t * 32 * KS_PITCH, lds + ALDS_V + t * VT_TILE, qf, m, l, o0, o1, r32, hi, true, [&](int) { return mine; });
            }
        } else {
            for (int t = 0; t <= w; ++t)
                attn_tile(lds + ALDS_K + t * 32 * KS_PITCH, lds + ALDS_V + t * VT_TILE, qf, m, l, o0, o1, r32, hi, t == w, [&](int kc) { return kc <= r32; });
        }
    }
    const float lt = l + __shfl_xor(l, 32);
    attn_store(QA + (rowbase + w * 32 + r32) * 512 + h * 64, 512, o0, o1, 1.0f / lt, hi);
}

__device__ __forceinline__ void swa_item(LAS unsigned char* lds, const Params& P, int layer, int b, int qh, int blk) {
    const int tid = tid_l(), lane = tid & 63, r32 = lane & 31, hi = lane >> 5; const int w = __builtin_amdgcn_readfirstlane(tid >> 6);
    bf16_t* QC = (bf16_t*)(wsl(P) + WS_QC); const bf16_t* KC = (const bf16_t*)(wsl(P) + WS_MISC); const bf16_t* VC = KC + 128;
    const int Q0 = blk * 256, kvh = qh >> 2;
    const size_t rowq = (size_t)b * SEQL + Q0 + w * 32 + r32;
    bf16x8 qf[4];
    { const bf16_t* qrow = QC + rowq * 512 + qh * 64;
#pragma unroll
      for (int ks = 0; ks < 4; ++ks) qf[ks] = *(const bf16x8*)(qrow + ks * 16 + hi * 8); }
    __syncthreads();
    const long kbase = (long)b * SEQL + Q0 - 128;
    stage_kv(lds, KC + kbase * 512 + kvh * 64, VC + kbase * 512 + kvh * 64, 512, 384, blk == 0 ? 128 : 0, tid);
    __syncthreads();
    float m = NEGF, l = 0.f; f32x16 o0, o1;
#pragma unroll
    for (int r = 0; r < 16; ++r) { o0[r] = 0.f; o1[r] = 0.f; }
    for (int tt = w; tt <= w + 4; ++tt) {
        if (blk == 0 && tt < 4) continue;
        if (tt == w) attn_tile(lds + ALDS_K + tt * 32 * KS_PITCH, lds + ALDS_V + tt * VT_TILE, qf, m, l, o0, o1, r32, hi, true, [&](int kc) { return kc > r32; });
        else if (tt == w + 4) attn_tile(lds + ALDS_K + tt * 32 * KS_PITCH, lds + ALDS_V + tt * VT_TILE, qf, m, l, o0, o1, r32, hi, true, [&](int kc) { return kc <= r32; });
        else attn_tile(lds + ALDS_K + tt * 32 * KS_PITCH, lds + ALDS_V + tt * VT_TILE, qf, m, l, o0, o1, r32, hi, false, [&](int) { return true; });
    }
    const float sk = P.sinks[layer * 8 + qh] * LOG2E;
    const float mn = fmaxf(m, sk); const float alpha = __builtin_amdgcn_exp2f(m - mn);
    const float lt = (l + __shfl_xor(l, 32)) * alpha + __builtin_amdgcn_exp2f(sk - mn);
    attn_store(QC + rowq * 512 + qh * 64, 512, o0, o1, alpha / lt, hi);
}

__device__ __forceinline__ void rwkv_prepass_item(LAS unsigned char* lds, const Params& P, int layer, int T, int h) {
    const int tid = tid_l(), tok = tid >> 3, c8 = tid & 7;
    bf16_t* RB = (bf16_t*)(wsl(P) + WS_RB); bf16_t* KB = (bf16_t*)(wsl(P) + WS_KB); bf16_t* VB = (bf16_t*)(wsl(P) + WS_VB);
    const bf16_t* LORA = (const bf16_t*)(wsl(P) + WS_MISC) + 256; const bf16_t* BND = (const bf16_t*)(wsl(P) + WS_BND);
    bf16_t* DW = (bf16_t*)(wsl(P) + WS_DW); bf16_t* KK = (bf16_t*)(wsl(P) + WS_KK); bf16_t* BB = (bf16_t*)(wsl(P) + WS_BB); float* RK = (float*)(wsl(P) + WS_RK);
    const float* mu = P.mu + layer * 2176;
    LAS float* L = (LAS float*)lds;
    LAS float* WU = (LAS float*)(lds + 32768);
    LAS float* AU = (LAS float*)(lds + 49152);
    const size_t row = (size_t)T * 64 + tok; const bool seq0 = ((row & (SEQL - 1)) == 0); const bool tile0 = (tok == 0);
    const int ch = h * 64 + c8 * 8;
    __syncthreads();
    u32x4 rc = *(const u32x4*)(RB + row * 512 + ch), kc = *(const u32x4*)(KB + row * 512 + ch), vc = *(const u32x4*)(VB + row * 512 + ch);
    u32x4 rp = {0u, 0u, 0u, 0u}, kp = rp, vp = rp;
    u32x4 lc0 = *(const u32x4*)(LORA + row * 512 + c8 * 16), lc1 = *(const u32x4*)(LORA + row * 512 + c8 * 16 + 8), lp0 = rp, lp1 = rp;
    if (!seq0) {
        if (tile0) { const bf16_t* bp = BND + (size_t)(T - 1) * 1664;
            rp = *(const u32x4*)(bp + ch); kp = *(const u32x4*)(bp + 512 + ch); vp = *(const u32x4*)(bp + 1024 + ch); lp0 = *(const u32x4*)(bp + 1536 + c8 * 16); lp1 = *(const u32x4*)(bp + 1536 + c8 * 16 + 8); }
        else { rp = *(const u32x4*)(RB + (row - 1) * 512 + ch); kp = *(const u32x4*)(KB + (row - 1) * 512 + ch); vp = *(const u32x4*)(VB + (row - 1) * 512 + ch);
            lp0 = *(const u32x4*)(LORA + (row - 1) * 512 + c8 * 16); lp1 = *(const u32x4*)(LORA + (row - 1) * 512 + c8 * 16 + 8); }
    }
    {
        const unsigned cw[8] = {lc0.x, lc0.y, lc0.z, lc0.w, lc1.x, lc1.y, lc1.z, lc1.w}; const unsigned pw[8] = {lp0.x, lp0.y, lp0.z, lp0.w, lp1.x, lp1.y, lp1.z, lp1.w};
#pragma unroll
        for (int i = 0; i < 8; ++i) {
            const int col = c8 * 16 + 2 * i;
            const float m0 = mu[1536 + col], m1 = mu[1536 + col + 1];
            float a = bflo(cw[i]), bq = bfhi(cw[i]); a = a + (bflo(pw[i]) - a) * m0; bq = bq + (bfhi(pw[i]) - bq) * m1;
            if (col < 64) { a = tanhf(a); bq = tanhf(bq); }
            L[tok * 128 + col] = a; L[tok * 128 + col + 1] = bq;
        }
    }
    for (int i = tid; i < 4096; i += NTHR) { WU[i] = P.w_up[(size_t)layer * 64 * 512 + (size_t)(i >> 6) * 512 + h * 64 + (i & 63)]; AU[i] = P.a_up[(size_t)layer * 64 * 512 + (size_t)(i >> 6) * 512 + h * 64 + (i & 63)]; }
    __syncthreads();
    float aw[8], aa[8];
#pragma unroll
    for (int i = 0; i < 8; ++i) { aw[i] = 0.f; aa[i] = 0.f; }
    for (int j = 0; j < 64; ++j) {
        const float lw = L[tok * 128 + j], la = L[tok * 128 + 64 + j];
        const f32x4 w0v = *(const LAS f32x4*)(WU + j * 64 + c8 * 8), w1v = *(const LAS f32x4*)(WU + j * 64 + c8 * 8 + 4);
        const f32x4 a0v = *(const LAS f32x4*)(AU + j * 64 + c8 * 8), a1v = *(const LAS f32x4*)(AU + j * 64 + c8 * 8 + 4);
#pragma unroll
        for (int i = 0; i < 4; ++i) { aw[i] += lw * w0v[i]; aw[4 + i] += lw * w1v[i]; aa[i] += la * a0v[i]; aa[4 + i] += la * a1v[i]; }
    }
    const unsigned rcw[4] = {rc.x, rc.y, rc.z, rc.w}, rpw[4] = {rp.x, rp.y, rp.z, rp.w}, kcw[4] = {kc.x, kc.y, kc.z, kc.w}, kpw[4] = {kp.x, kp.y, kp.z, kp.w}, vcw[4] = {vc.x, vc.y, vc.z, vc.w}, vpw[4] = {vp.x, vp.y, vp.z, vp.w};
    float rs[8], ks[8], vs[8], kkr[8], av[8], dw[8];
    float ss = 0.f;
#pragma unroll
    for (int i = 0; i < 8; ++i) {
        const int c = ch + i; const int wi = i >> 1; const bool hiw = i & 1;
        const float r0 = hiw ? bfhi(rcw[wi]) : bflo(rcw[wi]), r1 = hiw ? bfhi(rpw[wi]) : bflo(rpw[wi]);
        const float k0 = hiw ? bfhi(kcw[wi]) : bflo(kcw[wi]), k1 = hiw ? bfhi(kpw[wi]) : bflo(kpw[wi]);
        const float v0 = hiw ? bfhi(vcw[wi]) : bflo(vcw[wi]), v1 = hiw ? bfhi(vpw[wi]) : bflo(vpw[wi]);
        rs[i] = r0 + (r1 - r0) * mu[c]; ks[i] = k0 + (k1 - k0) * mu[512 + c]; vs[i] = v0 + (v1 - v0) * mu[1024 + c];
        const float sg = sigmoidf_(P.w0[layer * 512 + c] + aw[i]);
        dw[i] = 1.0f - __expf(-0.6065306597126334f * sg);
        av[i] = sigmoidf_(P.a0[layer * 512 + c] + aa[i]);
        kkr[i] = ks[i] * P.k_k[layer * 512 + c]; ss += kkr[i] * kkr[i];
    }
    ss += __shfl_xor(ss, 1); ss += __shfl_xor(ss, 2); ss += __shfl_xor(ss, 4);
    const float inv = 1.0f / fmaxf(sqrtf(ss), 1e-12f);
    float kq[8], kkn[8], bbv[8]; float rk = 0.f;
#pragma unroll
    for (int i = 0; i < 8; ++i) { const int c = ch + i; kkn[i] = kkr[i] * inv; kq[i] = ks[i] * (1.0f + (av[i] - 1.0f) * P.k_a[layer * 512 + c]); bbv[i] = kkn[i] * av[i]; rk += rs[i] * kq[i] * P.r_k[layer * 512 + c]; }
    rk += __shfl_xor(rk, 1); rk += __shfl_xor(rk, 2); rk += __shfl_xor(rk, 4);
    if (c8 == 0) RK[row * 8 + h] = rk;
    u32x4 o;
    o.x = pk2(rs[0], rs[1]); o.y = pk2(rs[2], rs[3]); o.z = pk2(rs[4], rs[5]); o.w = pk2(rs[6], rs[7]); *(u32x4*)(RB + row * 512 + ch) = o;
    o.x = pk2(kq[0], kq[1]); o.y = pk2(kq[2], kq[3]); o.z = pk2(kq[4], kq[5]); o.w = pk2(kq[6], kq[7]); *(u32x4*)(KB + row * 512 + ch) = o;
    o.x = pk2(vs[0], vs[1]); o.y = pk2(vs[2], vs[3]); o.z = pk2(vs[4], vs[5]); o.w = pk2(vs[6], vs[7]); *(u32x4*)(VB + row * 512 + ch) = o;
    o.x = pk2(dw[0], dw[1]); o.y = pk2(dw[2], dw[3]); o.z = pk2(dw[4], dw[5]); o.w = pk2(dw[6], dw[7]); *(u32x4*)(DW + row * 512 + ch) = o;
    o.x = pk2(kkn[0], kkn[1]); o.y = pk2(kkn[2], kkn[3]); o.z = pk2(kkn[4], kkn[5]); o.w = pk2(kkn[6], kkn[7]); *(u32x4*)(KK + row * 512 + ch) = o;
    o.x = pk2(bbv[0], bbv[1]); o.y = pk2(bbv[2], bbv[3]); o.z = pk2(bbv[4], bbv[5]); o.w = pk2(bbv[6], bbv[7]); *(u32x4*)(BB + row * 512 + ch) = o;
}

constexpr int NCH = 8, LCH = SEQL / NCH;
constexpr int SC_T = 32, SC_ARR = SC_T * 64 * 4, SC_SCAL = 6 * SC_ARR, SC_BUF = 6 * SC_ARR + 512, SC_Y = 2 * SC_BUF, SC_ROW = SC_Y + 4096;
template <int CTRL> __device__ __forceinline__ float dpp_mov(float v) { return __builtin_bit_cast(float, __builtin_amdgcn_update_dpp(0, __builtin_bit_cast(int, v), CTRL, 0xF, 0xF, true)); }
__device__ __forceinline__ float red8(float v) { v += dpp_mov<0xB1>(v); v += dpp_mov<0x4E>(v); v += dpp_mov<0x141>(v); return v; }
__device__ __forceinline__ void rwkv_scan_task(LAS unsigned char* lds, const Params& P, int bh, int c, int kind  ) {
    const int tid = tid_l(), lane = tid & 63, p = lane & 7; const int w = tid >> 6; const int irow = w * 8 + (lane >> 3);
    unsigned char* ws = wsl(P);
    const bf16_t* DWp = (const bf16_t*)(ws + WS_DW); const bf16_t* KKp = (const bf16_t*)(ws + WS_KK); const bf16_t* BBp = (const bf16_t*)(ws + WS_BB);
    const bf16_t* KBp = (const bf16_t*)(ws + WS_KB); const bf16_t* RBp = (const bf16_t*)(ws + WS_RB); const bf16_t* VBp = (const bf16_t*)(ws + WS_VB);
    bf16_t* OB = (bf16_t*)(ws + WS_OB); float* PL = (float*)(ws + WS_MISC);
    const int b = bh >> 3, h = bh & 7; const unsigned row0 = (unsigned)(b * SEQL + c * LCH); const int hc = h * 64;
    const bool use_v = (kind != 1);
    float s[8];
#pragma unroll
    for (int i = 0; i < 8; ++i) s[i] = (kind == 1 && (8 * p + i) == irow) ? 1.f : 0.f;
    __syncthreads();
    if (kind == 2 && c > 0) {
        { const float* L0 = PL + (size_t)((bh * NCH + 0) * 2 + 0) * 4096 + irow * 64 + 8 * p; const f32x4 a = *(const f32x4*)L0, d = *(const f32x4*)(L0 + 4);
          s[0] = a[0]; s[1] = a[1]; s[2] = a[2]; s[3] = a[3]; s[4] = d[0]; s[5] = d[1]; s[6] = d[2]; s[7] = d[3]; }
        LAS float* rowbuf = (LAS float*)(lds + SC_ROW) + irow * 64;
        for (int cc = 1; cc < c; ++cc) {
            const float* Pm = PL + (size_t)((bh * NCH + cc) * 2 + 1) * 4096; const float* Lm = PL + (size_t)((bh * NCH + cc) * 2 + 0) * 4096 + irow * 64 + 8 * p;
            *(LAS f32x4*)(rowbuf + 8 * p) = (f32x4){s[0], s[1], s[2], s[3]}; *(LAS f32x4*)(rowbuf + 8 * p + 4) = (f32x4){s[4], s[5], s[6], s[7]};
            LDS_WAIT();
            const f32x4 la = *(const f32x4*)Lm, lb = *(const f32x4*)(Lm + 4);
            float n[8] = {la[0], la[1], la[2], la[3], lb[0], lb[1], lb[2], lb[3]};
#pragma unroll 8
            for (int m = 0; m < 64; ++m) { const float sm = rowbuf[m]; const f32x4 pa = *(const f32x4*)(Pm + m * 64 + 8 * p), pb = *(const f32x4*)(Pm + m * 64 + 8 * p + 4);
#pragma unroll
                for (int i = 0; i < 4; ++i) { n[i] += sm * pa[i]; n[4 + i] += sm * pb[i]; } }
            LDS_WAIT();
#pragma unroll
            for (int i = 0; i < 8; ++i) s[i] = n[i];
        }
    }
    const int pc = tid & 255, lt = pc >> 3, lc8 = pc & 7, half = tid >> 8;
    u32x4 g0, g1, g2, g3;
    auto gload = [&](int tile) {
        const unsigned off = (row0 + (unsigned)(tile * SC_T + lt)) * 512u + (unsigned)(hc + lc8 * 8);
        if (half == 0) { g0 = *(const u32x4*)(DWp + off); g1 = *(const u32x4*)(RBp + off); g2 = *(const u32x4*)(KKp + off); }
        else { g0 = *(const u32x4*)(BBp + off); g1 = *(const u32x4*)(KBp + off); g2 = *(const u32x4*)(RBp + off); g3 = *(const u32x4*)(VBp + off); }
    };
    auto unpack = [&](const u32x4& u, f32x4& a, f32x4& d) { a[0] = bflo(u.x); a[1] = bfhi(u.x); a[2] = bflo(u.y); a[3] = bfhi(u.y); d[0] = bflo(u.z); d[1] = bfhi(u.z); d[2] = bflo(u.w); d[3] = bfhi(u.w); };
    auto lstore = [&](int buf) {
        LAS unsigned char* B = lds + buf * SC_BUF; const int e = (lt * 64 + lc8 * 8) * 4;
        f32x4 a0, a1, b0, b1, c0, c1;
        unpack(g0, a0, a1); unpack(g1, b0, b1); unpack(g2, c0, c1);
        if (half == 0) {
            a0 = 1.0f - a0; a1 = 1.0f - a1;
            *(LAS f32x4*)(B + 0 * SC_ARR + e) = a0; *(LAS f32x4*)(B + 0 * SC_ARR + e + 16) = a1;
            *(LAS f32x4*)(B + 4 * SC_ARR + e) = a0 * b0; *(LAS f32x4*)(B + 4 * SC_ARR + e + 16) = a1 * b1;
            *(LAS f32x4*)(B + 1 * SC_ARR + e) = c0; *(LAS f32x4*)(B + 1 * SC_ARR + e + 16) = c1;
        } else {
            f32x4 d0, d1; unpack(g3, d0, d1);
            *(LAS f32x4*)(B + 2 * SC_ARR + e) = a0; *(LAS f32x4*)(B + 2 * SC_ARR + e + 16) = a1;
            *(LAS f32x4*)(B + 3 * SC_ARR + e) = b0; *(LAS f32x4*)(B + 3 * SC_ARR + e + 16) = b1;
            if (!use_v) { d0 = (f32x4){0.f, 0.f, 0.f, 0.f}; d1 = d0; }
            *(LAS f32x4*)(B + 5 * SC_ARR + e) = d0; *(LAS f32x4*)(B + 5 * SC_ARR + e + 16) = d1;
            const f32x4 x = a0 * c0 + a1 * c1, y = b0 * c0 + b1 * c1;
            float br = (x[0] + x[1]) + (x[2] + x[3]), kr = (y[0] + y[1]) + (y[2] + y[3]);
            br = red8(br); kr = red8(kr);
            if (lc8 == 0) { LAS float* sc = (LAS float*)(B + SC_SCAL); sc[lt * 2] = br; sc[lt * 2 + 1] = kr; }
        }
    };
    gload(0); lstore(0);
    __syncthreads();
    constexpr int NTILE = LCH / SC_T;
    for (int tile = 0; tile < NTILE; ++tile) {
        const int buf = tile & 1;
        if (tile + 1 < NTILE) gload(tile + 1);
        const LAS unsigned char* B = lds + buf * SC_BUF;
        LAS unsigned short* ytile = (LAS unsigned short*)(lds + SC_Y);
#pragma unroll 4
        for (int t = 0; t < SC_T; ++t) {
            const int e = (t * 64 + p * 8) * 4;
            const f32x4 w0 = *(const LAS f32x4*)(B + 0 * SC_ARR + e), w1 = *(const LAS f32x4*)(B + 0 * SC_ARR + e + 16);
            const f32x4 q0 = *(const LAS f32x4*)(B + 1 * SC_ARR + e), q1 = *(const LAS f32x4*)(B + 1 * SC_ARR + e + 16);
            const f32x4 b0 = *(const LAS f32x4*)(B + 2 * SC_ARR + e), b1 = *(const LAS f32x4*)(B + 2 * SC_ARR + e + 16);
            const f32x4 k0 = *(const LAS f32x4*)(B + 3 * SC_ARR + e), k1 = *(const LAS f32x4*)(B + 3 * SC_ARR + e + 16);
            const f32x4 x0 = *(const LAS f32x4*)(B + 4 * SC_ARR + e), x1 = *(const LAS f32x4*)(B + 4 * SC_ARR + e + 16);
            const float v = *(const LAS float*)(B + 5 * SC_ARR + (t * 64 + irow) * 4);
            const float br = *(const LAS float*)(B + SC_SCAL + t * 8), kr = *(const LAS float*)(B + SC_SCAL + t * 8 + 4);
            float d1 = (s[0] * q0[0] + s[1] * q0[1]) + (s[2] * q0[2] + s[3] * q0[3]) + (s[4] * q1[0] + s[5] * q1[1]) + (s[6] * q1[2] + s[7] * q1[3]);
            float d2 = (s[0] * x0[0] + s[1] * x0[1]) + (s[2] * x0[2] + s[3] * x0[3]) + (s[4] * x1[0] + s[5] * x1[1]) + (s[6] * x1[2] + s[7] * x1[3]);
            d1 = red8(d1); d2 = red8(d2);
            const float sa = -d1;
#pragma unroll
            for (int i = 0; i < 4; ++i) { s[i] = s[i] * w0[i] + sa * b0[i] + v * k0[i]; s[4 + i] = s[4 + i] * w1[i] + sa * b1[i] + v * k1[i]; }
            if (kind == 2) { const float y = d2 + sa * br + v * kr; if (p == 0) ytile[t * 64 + irow] = (unsigned short)(pk2(y, 0.f) & 0xffffu); }
        }
        if (tile + 1 < NTILE) lstore(buf ^ 1);
        __syncthreads();
        if (kind == 2 && tid < 256) {
            const int t = tid >> 3, c8 = tid & 7;
            const u32x4 yv = *(const LAS u32x4*)(lds + SC_Y + (t * 64 + c8 * 8) * 2);
            *(u32x4*)(OB + (row0 + (unsigned)(tile * SC_T + t)) * 512u + (unsigned)(hc + c8 * 8)) = yv;
        }
        __syncthreads();
    }
    if (kind != 2) {
        float* dst = PL + (size_t)((bh * NCH + c) * 2 + kind) * 4096 + irow * 64 + 8 * p;
        *(f32x4*)dst = (f32x4){s[0], s[1], s[2], s[3]}; *(f32x4*)(dst + 4) = (f32x4){s[4], s[5], s[6], s[7]};
    }
}
__device__ __forceinline__ void rwkv_gn_row(const Params& P, int layer, size_t row, int lane) {
    bf16_t* OB = (bf16_t*)(wsl(P) + WS_OB); const bf16_t* VB = (const bf16_t*)(wsl(P) + WS_VB); const float* RK = (const float*)(wsl(P) + WS_RK);
    const int ch = lane * 8; const int h = lane >> 3;
    const u32x4 yv = *(const u32x4*)(OB + row * 512 + ch), vv = *(const u32x4*)(VB + row * 512 + ch);
    float y[8] = {bflo(yv.x), bfhi(yv.x), bflo(yv.y), bfhi(yv.y), bflo(yv.z), bfhi(yv.z), bflo(yv.w), bfhi(yv.w)};
    const float v[8] = {bflo(vv.x), bfhi(vv.x), bflo(vv.y), bfhi(vv.y), bflo(vv.z), bfhi(vv.z), bflo(vv.w), bfhi(vv.w)};
    float s = 0.f;
#pragma unroll
    for (int i = 0; i < 8; ++i) s += y[i];
    s += __shfl_xor(s, 1); s += __shfl_xor(s, 2); s += __shfl_xor(s, 4);
    const float mean = s * (1.f / 64.f); float q = 0.f;
#pragma unroll
    for (int i = 0; i < 8; ++i) { y[i] -= mean; q += y[i] * y[i]; }
    q += __shfl_xor(q, 1); q += __shfl_xor(q, 2); q += __shfl_xor(q, 4);
    const float rstd = 1.0f / sqrtf(q * (1.f / 64.f) + 64.0f * 1e-5f);
    const float rk = RK[row * 8 + h];
    const bf16_t* ZB = (const bf16_t*)(wsl(P) + WS_DW);
    const u32x4 zc = *(const u32x4*)(ZB + row * 512 + ch); u32x4 zp = {0u, 0u, 0u, 0u};
    if ((row & (SEQL - 1)) != 0) zp = *(const u32x4*)(ZB + (row - 1) * 512 + ch);
    const float z0[8] = {bflo(zc.x), bfhi(zc.x), bflo(zc.y), bfhi(zc.y), bflo(zc.z), bfhi(zc.z), bflo(zc.w), bfhi(zc.w)};
    const float z1[8] = {bflo(zp.x), bfhi(zp.x), bflo(zp.y), bfhi(zp.y), bflo(zp.z), bfhi(zp.z), bflo(zp.w), bfhi(zp.w)};
    float o[8];
#pragma unroll
    for (int i = 0; i < 8; ++i) { const float z = z0[i] + (z1[i] - z0[i]) * P.mu[layer * 2176 + 1664 + ch + i];
        o[i] = (y[i] * rstd * P.gn_g[layer * 512 + ch + i] + P.gn_b[layer * 512 + ch + i] + rk * v[i]) * z * sigmoidf_(z); }
    u32x4 ov; ov.x = pk2(o[0], o[1]); ov.y = pk2(o[2], o[3]); ov.z = pk2(o[4], o[5]); ov.w = pk2(o[6], o[7]);
    *(u32x4*)(OB + row * 512 + ch) = ov;
}

__global__ void __launch_bounds__(NTHR, 2) hybrid_fwd(Params P) {
    extern __shared__ __attribute__((aligned(16))) unsigned char lds_raw[];
    LAS unsigned char* lds = (LAS unsigned char*)lds_raw;
    cg::grid_group grid = cg::this_grid();
    LAS int* qslot = (LAS int*)(lds + 147440);

    for (int gs = 0; gs < NLAYER * 14; ++gs) {
        const int layer = gs / 14, st = gs % 14;
        int G = gridDim.x; asm volatile("" : "+s"(G)); const int NGW = G * 8;
        const int tid = tid_l(), lane = tid & 63; const int wave = __builtin_amdgcn_readfirstlane(tid >> 6); const int gw = blockIdx.x * 8 + wave;
        unsigned char* wsb = wsl(P);
        unsigned* ctl = (unsigned*)(wsb + WS_CTL);
        bf16_t* XB = (bf16_t*)(wsb + WS_XB); bf16_t* WIN = (bf16_t*)(wsb + WS_WIN); bf16_t* WBR = (bf16_t*)(wsb + WS_WBR); bf16_t* WOUT = (bf16_t*)(wsb + WS_WOUT);
        float* cosT = (float*)(wsb + WS_COS); float* sinT = (float*)(wsb + WS_SIN); float* KMEAN = (float*)(wsb + WS_KMEAN);
        const bool is_gemm = (st == 1 || st == 5 || st >= 7);
        if (is_gemm) {
            const bf16_t* A = XB; const bf16_t* Bt = WIN; int N = 1024, K = 1024, mode = 0, br = 0;
            if (st == 1) { N = 4096; }
            else if (st == 5) { Bt = WIN + (size_t)4096 * 1024; N = 1536; mode = 1; }
            else if (st == 13) { A = (const bf16_t*)(wsl(P) + WS_MERGED); Bt = WOUT; mode = 4; }
            else { br = (st - 7) >> 1;
                if (((st - 7) & 1) == 0) { A = (const bf16_t*)(wsl(P) + (br == 0 ? WS_QA : (br == 1 ? WS_OB : WS_QC))); Bt = WBR + (size_t)br * 1024 * 512; K = 512; mode = 2; }
                else { Bt = WIN + (size_t)(5632 + br * 1024) * 1024; mode = 3; } }
            pg8::Gemm g{A, Bt, MTOK, N, K}; pg8::StaticOrder S; S.init(MTOK, N, G, (int)blockIdx.x);
            EpiAll E{Epi1{wsl(P)}, EpiZ{wsl(P)}, EpiY{(bf16_t*)(wsl(P) + WS_Y)}, EpiG{(const bf16_t*)(wsl(P) + WS_Y), (bf16_t*)(wsl(P) + WS_MERGED), br == 0 ? 1 : 0}, EpiOut{layer == 0 ? P.x : (const float*)P.out, P.out}, mode};
            pg8::gemm_phase<EpiAll, pg8::StaticOrder, true, true>(lds, g, S, E);
            __syncthreads();
        } else if (st == 0) {
            LAS float* scr = (LAS float*)(lds + wave * 16384);
            constexpr int I_IN = 16 * 272, I_BR = 8 * 32, I_OUT = 16 * 32, NIT = I_IN + 3 * I_BR + I_OUT;
            for (int it = gw; it < NIT; it += NGW) {
                int r = it;
                if (r < I_IN) { const int kb = r / 272, nb = r % 272; transpose_item(P.w_in + (size_t)layer * DM * INW, INW, WIN, 1024, kb * 64, nb * 32, win_map(nb * 32 + (lane & 31)), scr, lane); continue; }
                r -= I_IN;
                if (r < 3 * I_BR) { const int br = r / I_BR, q = r % I_BR, kb = q / 32, nb = q % 32; const float* W = (br == 0 ? P.wba : br == 1 ? P.wbb : P.wbc) + (size_t)layer * 512 * 1024;
                    transpose_item(W, 1024, WBR + (size_t)br * 1024 * 512, 512, kb * 64, nb * 32, nb * 32 + (lane & 31), scr, lane); continue; }
                r -= 3 * I_BR;
                { const int kb = r / 32, nb = r % 32; transpose_item(P.w_out + (size_t)layer * 1024 * 1024, 1024, WOUT, 1024, kb * 64, nb * 32, nb * 32 + (lane & 31), scr, lane); }
            }
            for (int m = gw; m < MTOK; m += NGW) {
                if (layer == 0) row_to_bf16(P.x + (size_t)m * DM, nullptr, XB + (size_t)m * DM, nullptr, nullptr, false, lane);
                else row_to_bf16(P.out + (size_t)m * DM, P.out + (size_t)m * DM, XB + (size_t)m * DM, P.ln_g + (layer - 1) * DM, P.ln_b + (layer - 1) * DM, true, lane);
            }
            if (layer == 0) {
                for (int i = blockIdx.x * NTHR + tid; i < MTOK * 32; i += G * NTHR) { const int m = i >> 5, f = i & 31;
                    const float inv = powf(10000.0f, -(float)f / 32.0f); const float ang = (float)P.pos[m] * inv; cosT[i] = cosf(ang); sinT[i] = sinf(ang); }
            }
            for (int i = blockIdx.x * NTHR + tid; i < 64 * 512; i += G * NTHR) KMEAN[i] = 0.f;
        } else if (st == 2) {
            unsigned* ctr = ctl + 64 * (1 + layer * 4);
            for (;;) {
                __syncthreads();
                if (tid == 0) *qslot = (int)atomicAdd(ctr, 1u);
                __syncthreads();
                const int it = *qslot;
                if (it >= 2048 + 512) break;
                if (it < 512) { const int b = it >> 8, qh = (it >> 5) & 7, blk = it & 31; swa_item(lds, P, layer, b, qh, blk); }
                else { const int q = it - 512; rwkv_prepass_item(lds, P, layer, q >> 3, q & 7); }
            }
        } else if (st == 3) {
            for (int t = blockIdx.x; t < 16 * 13; t += G) {
                if (t < 16 * 7) rwkv_scan_task(lds, P, t / 7, t % 7, 0);
                else { const int q = t - 16 * 7; rwkv_scan_task(lds, P, q / 6, 1 + q % 6, 1); }
            }
        } else if (st == 4) {
            for (int t = blockIdx.x; t < 16 * NCH; t += G) rwkv_scan_task(lds, P, t >> 3, t & 7, 2);
            unsigned* ctr = ctl + 64 * (2 + layer * 4);
            for (;;) {
                __syncthreads();
                if (tid == 0) *qslot = (int)atomicAdd(ctr, 1u);
                __syncthreads();
                const int it = *qslot;
                if (it >= 512) break;
                const int n = 31 - (it >> 4), bh = it & 15;
                moba_item(lds_raw, lds, P, bh >> 3, bh & 7, n);
            }
        } else {
            for (int m = gw; m < MTOK; m += NGW) rwkv_gn_row(P, layer, (size_t)m, lane);
        }
        if (!(st >= 7 && st <= 11)) grid.sync();
    }
    { const int tid = tid_l(), lane = tid & 63; const int gw = blockIdx.x * 8 + (tid >> 6); const int NGW = gridDim.x * 8;
      for (int m = gw; m < MTOK; m += NGW) row_to_bf16(P.out + (size_t)m * DM, P.out + (size_t)m * DM, nullptr, P.ln_g + DM, P.ln_b + DM, true, lane); }
}

extern "C" void kernel_launch(void* const* d_in, const int* in_sizes, int n_in, void* d_out, int out_size, void* d_ws, size_t ws_size, hipStream_t stream) {
    static int grid = 0;
    if (grid == 0) {
        if (n_in != 20 || ws_size < WS_END) { fprintf(stderr, "kernel_launch: unexpected inputs (n_in %d, ws %zu)\n", n_in, ws_size); grid = -1; return; }
        int dev = 0, cus = 0, per_cu = 0;
        hipGetDevice(&dev); hipDeviceGetAttribute(&cus, hipDeviceAttributeMultiprocessorCount, dev);
        hipFuncSetAttribute((const void*)hybrid_fwd, hipFuncAttributeMaxDynamicSharedMemorySize, LDS_BYTES);
        hipOccupancyMaxActiveBlocksPerMultiprocessor(&per_cu, (const void*)hybrid_fwd, NTHR, LDS_BYTES);
        if (per_cu < 1) { fprintf(stderr, "kernel_launch: occupancy query says %d blocks per CU\n", per_cu); per_cu = 1; }
        grid = cus;
    }
    if (grid < 0) return;
    hipMemsetAsync((char*)d_ws + WS_CTL, 0, 1 * MiB, stream);
    Params p{};
    p.x = (const float*)d_in[0]; p.pos = (const int*)d_in[1]; p.w_in = (const float*)d_in[2]; p.mu = (const float*)d_in[3]; p.w0 = (const float*)d_in[4]; p.w_up = (const float*)d_in[5];
    p.a0 = (const float*)d_in[6]; p.a_up = (const float*)d_in[7]; p.k_k = (const float*)d_in[8]; p.k_a = (const float*)d_in[9]; p.r_k = (const float*)d_in[10]; p.gn_g = (const float*)d_in[11];
    p.gn_b = (const float*)d_in[12]; p.sinks = (const float*)d_in[13]; p.wba = (const float*)d_in[14]; p.wbb = (const float*)d_in[15]; p.wbc = (const float*)d_in[16]; p.w_out = (const float*)d_in[17];
    p.ln_g = (const float*)d_in[18]; p.ln_b = (const float*)d_in[19]; p.out = (float*)d_out; p.ws = (unsigned char*)d_ws;
    void* args[] = {&p};
    hipError_t e = hipLaunchCooperativeKernel((const void*)hybrid_fwd, dim3(grid), dim3(NTHR), args, LDS_BYTES, stream);
    if (e != hipSuccess) fprintf(stderr, "cooperative launch failed: %s (grid %d)\n", hipGetErrorString(e), grid);
}
```

```cpp
#include <hip/hip_runtime.h>
#include <hip/hip_cooperative_groups.h>
#include <cstdio>
#include <cstdint>
namespace cg = cooperative_groups;
__device__ __forceinline__ int tid_l() { int t = threadIdx.x; asm volatile("" : "+v"(t)); return t; }
namespace pg8 {
#define PG8_LAS __attribute__((address_space(3)))
typedef unsigned short bf16_t;
typedef short bf16x8 __attribute__((ext_vector_type(8)));
typedef float f32x4 __attribute__((ext_vector_type(4)));
typedef unsigned u32x4 __attribute__((ext_vector_type(4)));
constexpr int BM = 256, BK = 64, HALF = 128, HTB = HALF * BK * 2  , STAGE_BYTES = 8 * HTB, NXCD = 8, WGM = 8;

__host__ __device__ __forceinline__ int lds_byte(int r, int c) { const int st = (r >> 4) * 2 + (c >> 5), rr = r & 15, cc = c & 31, ob = rr * 64 + cc * 2; return st * 1024 + (ob ^ (((ob >> 9) & 1) << 5)); }
__host__ __device__ __forceinline__ void stage_rc(int b, int& R, int& C) { const int st = b / 1024, sb = b % 1024, swz = sb ^ (((sb >> 9) & 1) << 5); R = (st >> 1) * 16 + swz / 64; C = (st & 1) * 32 + (swz % 64) / 2; }
__host__ __device__ __forceinline__ int perm32(int rho) { const int n = rho >> 4, i = rho & 15; return 8 * (i >> 2) + 4 * n + (i & 3); }

struct Unit { int pm, pn; };
struct Gemm { const bf16_t* A; const bf16_t* Bt; int M, N, K; };

struct StaticOrder {
    int nM, nN, nwg, G, c;
    __host__ __device__ void init(int M, int N, int G_, int c_) { nM = M / BM; nN = N / BM; nwg = nM * nN; G = G_; c = c_; }
    __host__ __device__ bool next(int i, Unit& u) const {
        const long L = (long)i * G + c; if (L >= nwg) return false;
        int wgid = (int)L; { const int q = nwg / NXCD, r = nwg % NXCD, xcd = wgid % NXCD, off = wgid / NXCD; wgid = (xcd < r ? xcd * (q + 1) : r * (q + 1) + (xcd - r) * q) + off; }
        const int nig = WGM * nN, gid = wgid / nig, fm = gid * WGM, gsz = (nM - fm) < WGM ? (nM - fm) : WGM;
        u.pm = fm + ((wgid % nig) % gsz); u.pn = (wgid % nig) / gsz; return true;
    }
    __device__ __forceinline__ void a_ready(const Unit&) const {}
    __device__ __forceinline__ void done(const Unit&) const {}
};

__device__ __forceinline__ unsigned cvt_pk_bf16(float lo, float hi) { unsigned r; asm volatile("v_cvt_pk_bf16_f32 %0, %1, %2" : "=v"(r) : "v"(lo), "v"(hi)); return r; }
template <class Epi, class Sched, bool ALIGN_EPI = false, bool SP2 = false>
__device__ __forceinline__ void gemm_phase(PG8_LAS unsigned char* lds, const Gemm g, const Sched& S, const Epi& E) {
    const int tid = tid_l(), wid = __builtin_amdgcn_readfirstlane(tid >> 6), lane = tid & 63, wr = wid >> 2, wc = wid & 3, fr = lane & 15, fq = lane >> 4;
    const int K = g.K, nt = K / BK;
    unsigned voffA[2], voffB[2];
#pragma unroll
    for (int i = 0; i < 2; ++i) { int R, C; stage_rc(tid * 16 + i * 8192, R, C); const int Rb = Epi::PERM ? ((R & ~31) + perm32(R & 31)) : R;
        voffA[i] = (unsigned)(R * K + C) * 2u; voffB[i] = (unsigned)(Rb * K + C) * 2u; }
    const size_t kstep = (size_t)(BK * 2);
    const size_t hstep = (size_t)HALF * K * 2;
    const size_t tstep = 2 * hstep;
    const unsigned ldsw = (unsigned)wid * 1024u;
    const int aoff = lds_byte(wr * 64 + fr, fq * 8), boff = lds_byte(wc * 32 + fr, fq * 8);
#define PG8_SA(b, h) (((b) * 2 + (h)) * HTB)
#define PG8_SB(b, h) ((4 + (b) * 2 + (h)) * HTB)
#define PG8_STAGE(bufoff, gbase, voff) do { _Pragma("unroll") for (int _i = 0; _i < 2; ++_i) \
        __builtin_amdgcn_global_load_lds((const unsigned*)((const char*)(gbase) + (voff)[_i]), (PG8_LAS unsigned*)(lds + (bufoff) + ldsw + _i * 8192), 16, 0, 0); } while (0)
#define PG8_LDA(dst, b, h) do { _Pragma("unroll") for (int m = 0; m < 4; ++m) _Pragma("unroll") for (int k = 0; k < 2; ++k) dst[m][k] = *(const PG8_LAS bf16x8*)(lds + PG8_SA(b, h) + aoff + m * 2048 + k * 1024); } while (0)
#define PG8_LDB(dst, b, h) do { _Pragma("unroll") for (int n = 0; n < 2; ++n) _Pragma("unroll") for (int k = 0; k < 2; ++k) dst[n][k] = *(const PG8_LAS bf16x8*)(lds + PG8_SB(b, h) + boff + n * 2048 + k * 1024); } while (0)
#define PG8_MMA(ai, bj, At, Bt) do { __builtin_amdgcn_s_setprio(1); _Pragma("unroll") for (int m = 0; m < 4; ++m) _Pragma("unroll") for (int n = 0; n < 2; ++n) _Pragma("unroll") for (int k = 0; k < 2; ++k) \
        acc[ai][bj][m][n] = __builtin_amdgcn_mfma_f32_16x16x32_bf16(Bt[n][k], At[m][k], acc[ai][bj][m][n], 0, 0, 0); __builtin_amdgcn_s_setprio(0); } while (0)
#define PG8_WAIT_V(n) asm volatile("s_waitcnt vmcnt(" #n ")" ::: "memory")
#define PG8_WAIT_L(n) asm volatile("s_waitcnt lgkmcnt(" #n ")" ::: "memory")
#define PG8_BAR __builtin_amdgcn_s_barrier()
#define PG8_SCHED __builtin_amdgcn_sched_barrier(0)
    Unit cur, nxt; int ui = 0;
    if (!S.next(0, cur)) return;
    f32x4 acc[2][2][4][2];
#pragma unroll
    for (int a = 0; a < 2; ++a)
#pragma unroll
        for (int b = 0; b < 2; ++b)
#pragma unroll
            for (int m = 0; m < 4; ++m)
#pragma unroll
                for (int n = 0; n < 2; ++n) acc[a][b][m][n] = (f32x4){0.f, 0.f, 0.f, 0.f};
    bf16x8 At[4][2], B0[2][2], B1[2][2];
    const char* cA = (const char*)g.A + (size_t)cur.pm * tstep; const char* cB = (const char*)g.Bt + (size_t)cur.pn * tstep;
    S.a_ready(cur);
    if constexpr (SP2) {
        PG8_STAGE(PG8_SB(0, 0), cB, voffB); PG8_STAGE(PG8_SB(0, 1), cB + hstep, voffB); PG8_STAGE(PG8_SA(0, 0), cA, voffA); PG8_STAGE(PG8_SA(0, 1), cA + hstep, voffA);
        if (wr == 1) PG8_BAR;
        PG8_WAIT_V(2); PG8_BAR;
        PG8_STAGE(PG8_SB(1, 0), cB + kstep, voffB); PG8_STAGE(PG8_SA(1, 0), cA + kstep, voffA); PG8_STAGE(PG8_SB(1, 1), cB + hstep + kstep, voffB);
        PG8_WAIT_V(6); PG8_BAR;
    } else {
        PG8_STAGE(PG8_SB(0, 0), cB, voffB); PG8_STAGE(PG8_SA(0, 0), cA, voffA); PG8_STAGE(PG8_SB(0, 1), cB + hstep, voffB); PG8_STAGE(PG8_SA(0, 1), cA + hstep, voffA);
        if (wr == 1) PG8_BAR;
        PG8_WAIT_V(4); PG8_BAR;
        PG8_STAGE(PG8_SB(1, 0), cB + kstep, voffB); PG8_STAGE(PG8_SA(1, 0), cA + kstep, voffA); PG8_STAGE(PG8_SB(1, 1), cB + hstep + kstep, voffB);
        PG8_WAIT_V(6); PG8_BAR;
    }
    for (;;) {
        const bool has_next = S.next(ui + 1, nxt);
        const char* nA = has_next ? (const char*)g.A + (size_t)nxt.pm * tstep : cA; const char* nB = has_next ? (const char*)g.Bt + (size_t)nxt.pn * tstep : cB;
        for (int t = 0; t < nt; t += 2) {
            const bool last = (t == nt - 2);
            const char* a1 = cA + (size_t)(t + 1) * kstep;
            const char* a2 = last ? nA : cA + (size_t)(t + 2) * kstep; const char* b2 = last ? nB : cB + (size_t)(t + 2) * kstep;
            const char* a3 = a2 + kstep; const char* b3 = b2 + kstep;
            if (last && has_next) S.a_ready(nxt);
            if constexpr (SP2) {
            PG8_LDB(B0, 0, 0); PG8_LDB(B1, 0, 1); PG8_SCHED; PG8_LDA(At, 0, 0); PG8_STAGE(PG8_SA(1, 1), a1 + hstep, voffA);
            PG8_WAIT_V(8); PG8_WAIT_L(0); PG8_BAR; PG8_MMA(0, 0, At, B0); PG8_MMA(0, 1, At, B1); PG8_BAR; PG8_SCHED;
            PG8_LDA(At, 0, 1); PG8_STAGE(PG8_SB(0, 0), b2, voffB); PG8_STAGE(PG8_SB(0, 1), b2 + hstep, voffB); PG8_STAGE(PG8_SA(0, 0), a2, voffA);
            PG8_WAIT_V(8); PG8_WAIT_L(0); PG8_BAR; PG8_MMA(1, 0, At, B0); PG8_MMA(1, 1, At, B1); PG8_BAR; PG8_SCHED;
            PG8_LDB(B0, 1, 0); PG8_LDB(B1, 1, 1); PG8_SCHED; PG8_LDA(At, 1, 0); PG8_STAGE(PG8_SA(0, 1), a2 + hstep, voffA);
            PG8_WAIT_V(8); PG8_WAIT_L(0); PG8_BAR; PG8_MMA(0, 0, At, B0); PG8_MMA(0, 1, At, B1); PG8_BAR; PG8_SCHED;
            PG8_LDA(At, 1, 1); PG8_STAGE(PG8_SB(1, 0), b3, voffB); PG8_STAGE(PG8_SB(1, 1), b3 + hstep, voffB); PG8_STAGE(PG8_SA(1, 0), a3, voffA);
            PG8_WAIT_V(8); PG8_WAIT_L(0); PG8_BAR; PG8_MMA(1, 0, At, B0); PG8_MMA(1, 1, At, B1); PG8_BAR; PG8_SCHED;
            } else {
            PG8_LDB(B0, 0, 0); PG8_SCHED; PG8_LDA(At, 0, 0); PG8_STAGE(PG8_SA(1, 1), a1 + hstep, voffA);
            PG8_WAIT_L(8); PG8_BAR; PG8_WAIT_L(0); PG8_MMA(0, 0, At, B0); PG8_BAR; PG8_SCHED;
            PG8_LDB(B1, 0, 1); PG8_STAGE(PG8_SB(0, 0), b2, voffB);
            PG8_BAR; PG8_WAIT_L(0); PG8_MMA(0, 1, At, B1); PG8_BAR;
            PG8_LDA(At, 0, 1); PG8_STAGE(PG8_SA(0, 0), a2, voffA);
            PG8_BAR; PG8_WAIT_L(0); PG8_MMA(1, 0, At, B0); PG8_BAR; PG8_SCHED;
            PG8_STAGE(PG8_SB(0, 1), b2 + hstep, voffB);
            PG8_WAIT_V(6); PG8_BAR; PG8_MMA(1, 1, At, B1); PG8_BAR;
            PG8_LDB(B0, 1, 0); PG8_SCHED; PG8_LDA(At, 1, 0); PG8_STAGE(PG8_SA(0, 1), a2 + hstep, voffA);
            PG8_WAIT_L(8); PG8_BAR; PG8_WAIT_L(0); PG8_MMA(0, 0, At, B0); PG8_BAR; PG8_SCHED;
            PG8_LDB(B1, 1, 1); PG8_STAGE(PG8_SB(1, 0), b3, voffB);
            PG8_BAR; PG8_WAIT_L(0); PG8_MMA(0, 1, At, B1); PG8_BAR;
            PG8_LDA(At, 1, 1); PG8_STAGE(PG8_SA(1, 0), a3, voffA);
            PG8_BAR; PG8_WAIT_L(0); PG8_MMA(1, 0, At, B0); PG8_BAR; PG8_SCHED;
            PG8_STAGE(PG8_SB(1, 1), b3 + hstep, voffB);
            PG8_WAIT_V(6); PG8_BAR; PG8_MMA(1, 1, At, B1); PG8_BAR;
            }
        }
        if constexpr (ALIGN_EPI) { if (wr == 0) PG8_BAR; }
        if constexpr (!Epi::AFTER_DRAIN) { E(acc, cur, wr, wc, fr, fq); S.done(cur); }
        if (!has_next) break;
#pragma unroll
        for (int a = 0; a < 2; ++a)
#pragma unroll
            for (int b = 0; b < 2; ++b)
#pragma unroll
                for (int m = 0; m < 4; ++m)
#pragma unroll
                    for (int n = 0; n < 2; ++n) acc[a][b][m][n] = (f32x4){0.f, 0.f, 0.f, 0.f};
        cur = nxt; cA = nA; cB = nB; ++ui;
        if constexpr (ALIGN_EPI) { if (wr == 1) PG8_BAR; }
    }
    PG8_WAIT_V(0);
    if constexpr (!ALIGN_EPI) { if (wr == 0) PG8_BAR; }
    PG8_BAR;
    if constexpr (Epi::AFTER_DRAIN) { E.fused(acc, cur, wr, wc, fr, fq, lds, wid, lane); S.done(cur); }
#undef PG8_SA
#undef PG8_SB
#undef PG8_STAGE
#undef PG8_LDA
#undef PG8_LDB
#undef PG8_MMA
#undef PG8_WAIT_V
#undef PG8_WAIT_L
#undef PG8_BAR
#undef PG8_SCHED
}
}

#define LAS __attribute__((address_space(3)))
using pg8::bf16_t; using pg8::bf16x8; using pg8::f32x4; using pg8::Unit;
typedef float f32x16 __attribute__((ext_vector_type(16)));
typedef unsigned u32x4 __attribute__((ext_vector_type(4)));
typedef unsigned u32x2 __attribute__((ext_vector_type(2)));

constexpr int MTOK = 16384, SEQL = 8192, DM = 1024, INW = 8576, NLAYER = 2;
constexpr float C2F = 0.125f * 1.4426950408889634f;
constexpr float LOG2E = 1.4426950408889634f;
constexpr float NEGF = -1.0e30f;
constexpr float ALPHA_RES = 1.4142135623730951f;
constexpr int NTHR = 512;
#ifndef PHMASK
#define PHMASK 0x1ff
#endif
constexpr int LDS_BYTES = 147456;

constexpr size_t MiB = 1u << 20;
constexpr size_t WS_CTL = 0;
constexpr size_t WS_COS = 1 * MiB;
constexpr size_t WS_SIN = 3 * MiB;
constexpr size_t WS_KMEAN = 5 * MiB;
constexpr size_t WS_RK = 5 * MiB + 256 * 1024;
constexpr size_t WS_BND = 6 * MiB;
constexpr size_t WS_XB = 7 * MiB;
constexpr size_t WS_WIN = 39 * MiB;
constexpr size_t WS_WBR = 56 * MiB;
constexpr size_t WS_WOUT = 59 * MiB;
constexpr size_t WS_QA = 61 * MiB;
constexpr size_t WS_KA = 77 * MiB;
constexpr size_t WS_VA = 93 * MiB;
constexpr size_t WS_RB = 109 * MiB;
constexpr size_t WS_KB = 125 * MiB;
constexpr size_t WS_VB = 141 * MiB;
constexpr size_t WS_MISC = 157 * MiB;
constexpr size_t WS_OB = 173 * MiB;
constexpr size_t WS_QC = 189 * MiB;
constexpr size_t WS_DW = 205 * MiB;
constexpr size_t WS_KK = 221 * MiB;
constexpr size_t WS_BB = 237 * MiB;
constexpr size_t WS_END = 253 * MiB;
constexpr size_t WS_Y = WS_KA;
constexpr size_t WS_MERGED = WS_RB;

__device__ __forceinline__ float bflo(unsigned u) { return __uint_as_float(u << 16); }
__device__ __forceinline__ float bfhi(unsigned u) { return __uint_as_float(u & 0xffff0000u); }
__device__ __forceinline__ unsigned pk2(float lo, float hi) { return pg8::cvt_pk_bf16(lo, hi); }
__device__ __forceinline__ float sigmoidf_(float x) { return __builtin_amdgcn_rcpf(1.0f + __expf(-x)); }
__device__ __forceinline__ int crow(int r, int hi) { return (r & 3) + 8 * (r >> 2) + 4 * hi; }
#define LDS_WAIT() asm volatile("s_waitcnt lgkmcnt(0)" ::: "memory")

struct Params;
__device__ __forceinline__ unsigned char* wsl(const Params& P);
struct Params {
    const float* x; const int* pos; const float* w_in; const float* mu; const float* w0; const float* w_up; const float* a0; const float* a_up;
    const float* k_k; const float* k_a; const float* r_k; const float* gn_g; const float* gn_b; const float* sinks;
    const float* wba; const float* wbb; const float* wbc; const float* w_out; const float* ln_g; const float* ln_b;
    float* out; unsigned char* ws;
};

typedef __attribute__((address_space(1))) unsigned char gas_uchar;
__device__ __forceinline__ unsigned char* wsl(const Params& P) { gas_uchar* w = (gas_uchar*)P.ws; asm volatile("" : "+s"(w)); return (unsigned char*)w; }

struct Epi1 {
    static constexpr bool PERM = false, AFTER_DRAIN = false;
    unsigned char* ws;
    __device__ __forceinline__ void operator()(const f32x4 (&acc)[2][2][4][2], const Unit& u, int wr, int wc, int fr, int fq) const {
        const int pn = u.pn; const int row0 = u.pm * 256 + wr * 64 + fr;
        const float* cosT = (const float*)(ws + WS_COS); const float* sinT = (const float*)(ws + WS_SIN); float* KMEAN = (float*)(ws + WS_KMEAN); bf16_t* BND = (bf16_t*)(ws + WS_BND);
#pragma unroll
        for (int bj = 0; bj < 2; ++bj) {
            int kind = 0; size_t doff = 0; constexpr int pitch = 512; int cb = 0; float sc = 1.f; int bcol = -1; const int tcol = 128 * bj;
            if (pn < 12) { doff = WS_QA + (size_t)(pn >> 1) * (16 * MiB); cb = (pn & 1) * 256 + tcol; kind = pn < 4 ? 1 : 0; if (pn < 2) sc = C2F; if (pn >= 6) bcol = ((pn - 6) >> 1) * 512 + cb; }
            else if (pn == 12) { if (bj == 0) { doff = WS_MISC; cb = 256; bcol = 1536; } else kind = 2; }
            else if (pn < 15) { kind = 1; doff = WS_QC; cb = (pn - 13) * 256 + tcol; sc = C2F; }
            else { doff = WS_MISC; if (bj == 0) { kind = 1; cb = 0; } else { cb = 128; } }
            bf16_t* dst = (bf16_t*)(ws + doff);
            if (kind == 2) continue;
            if (kind == 0) {
#pragma unroll
                for (int ai = 0; ai < 2; ++ai)
#pragma unroll
                    for (int m = 0; m < 4; ++m) { const int row = row0 + ai * 128 + m * 16;
#pragma unroll
                        for (int n = 0; n < 2; ++n) { const f32x4 v = acc[ai][bj][m][n]; u32x2 w; w.x = pk2(v[0], v[1]); w.y = pk2(v[2], v[3]);
                            const int c = 32 * wc + 16 * n + 4 * fq;
                            *(u32x2*)(dst + (unsigned)(row * pitch + cb + c)) = w;
                            if (bcol >= 0 && m == 3 && fr == 15) *(u32x2*)(BND + (unsigned)((row >> 6) * 1664 + bcol + c)) = w; }
                        asm volatile("" ::: "memory"); }
            } else {
                const int f0 = 16 * (wc & 1) + 4 * fq; const int c1 = cb + 64 * (wc >> 1) + f0;
                const bool km = (pn == 2 || pn == 3);
                f32x4 s1 = {0.f, 0.f, 0.f, 0.f}, s2 = {0.f, 0.f, 0.f, 0.f};
#pragma unroll
                for (int ai = 0; ai < 2; ++ai) {
                    f32x4 cs[4], sn[4];
#pragma unroll
                    for (int m = 0; m < 4; ++m) { const int row = row0 + ai * 128 + m * 16; cs[m] = *(const f32x4*)(cosT + (unsigned)(row * 32 + f0)); sn[m] = *(const f32x4*)(sinT + (unsigned)(row * 32 + f0)); }
#pragma unroll
                    for (int m = 0; m < 4; ++m) { const int row = row0 + ai * 128 + m * 16;
                        const f32x4 x1 = acc[ai][bj][m][0], x2 = acc[ai][bj][m][1];
                        const f32x4 o1 = x1 * cs[m] - x2 * sn[m], o2 = x2 * cs[m] + x1 * sn[m];
                        s1 += o1; s2 += o2;
                        u32x2 w; w.x = pk2(o1[0] * sc, o1[1] * sc); w.y = pk2(o1[2] * sc, o1[3] * sc);
                        *(u32x2*)(dst + (unsigned)(row * pitch + c1)) = w;
                        w.x = pk2(o2[0] * sc, o2[1] * sc); w.y = pk2(o2[2] * sc, o2[3] * sc);
                        *(u32x2*)(dst + (unsigned)(row * pitch + c1 + 32)) = w; }
                    asm volatile("" ::: "memory");
                }
                if (km) {
#pragma unroll
                    for (int j = 0; j < 4; ++j) {
                        float a = s1[j], b = s2[j];
#pragma unroll
                        for (int o = 1; o < 16; o <<= 1) { a += __shfl_xor(a, o); b += __shfl_xor(b, o); }
                        if (fr == 0) { atomicAdd(KMEAN + (unsigned)(u.pm * 512 + c1 + j), a); atomicAdd(KMEAN + (unsigned)(u.pm * 512 + c1 + 32 + j), b); }
                    }
                }
            }
        }
    }
};

struct EpiZ {
    static constexpr bool PERM = false, AFTER_DRAIN = false;
    unsigned char* ws;
    __device__ __forceinline__ void operator()(const f32x4 (&acc)[2][2][4][2], const Unit& u, int wr, int wc, int fr, int fq) const {
        const int br = u.pn >> 1; bf16_t* O = (bf16_t*)(ws + (br == 0 ? WS_QA : (br == 1 ? WS_DW : WS_QC)));
        const int row0 = u.pm * 256 + wr * 64 + fr; const int cb = (u.pn & 1) * 256 + 32 * wc + 4 * fq;
#pragma unroll
        for (int ai = 0; ai < 2; ++ai)
#pragma unroll
            for (int mh = 0; mh < 2; ++mh) {
                u32x2 o[2][2][2];
                if (br != 1) {
#pragma unroll
                    for (int mm = 0; mm < 2; ++mm) { const int row = row0 + ai * 128 + (mh * 2 + mm) * 16;
#pragma unroll
                        for (int bj = 0; bj < 2; ++bj)
#pragma unroll
                            for (int n = 0; n < 2; ++n) o[mm][bj][n] = *(const u32x2*)(O + (unsigned)(row * 512 + cb + 128 * bj + 16 * n)); }
                }
#pragma unroll
                for (int mm = 0; mm < 2; ++mm) { const int m = mh * 2 + mm; const int row = row0 + ai * 128 + m * 16;
#pragma unroll
                    for (int bj = 0; bj < 2; ++bj)
#pragma unroll
                        for (int n = 0; n < 2; ++n) { const f32x4 z = acc[ai][bj][m][n]; u32x2 w;
                            if (br == 1) { w.x = pk2(z[0], z[1]); w.y = pk2(z[2], z[3]); }
                            else { const u32x2 ov = o[mm][bj][n];
                                w.x = pk2(bflo(ov.x) * z[0] * sigmoidf_(z[0]), bfhi(ov.x) * z[1] * sigmoidf_(z[1]));
                                w.y = pk2(bflo(ov.y) * z[2] * sigmoidf_(z[2]), bfhi(ov.y) * z[3] * sigmoidf_(z[3])); }
                            *(u32x2*)(O + (unsigned)(row * 512 + cb + 128 * bj + 16 * n)) = w; } }
                asm volatile("" ::: "memory");
            }
    }
};

struct EpiY {
    static constexpr bool PERM = false, AFTER_DRAIN = false;
    bf16_t* Y;
    __device__ __forceinline__ void operator()(const f32x4 (&acc)[2][2][4][2], const Unit& u, int wr, int wc, int fr, int fq) const {
        const int row0 = u.pm * 256 + wr * 64 + fr; const int cb = u.pn * 256 + 32 * wc + 4 * fq;
#pragma unroll
        for (int ai = 0; ai < 2; ++ai)
#pragma unroll
            for (int m = 0; m < 4; ++m) { const int row = row0 + ai * 128 + m * 16;
#pragma unroll
                for (int bj = 0; bj < 2; ++bj)
#pragma unroll
                    for (int n = 0; n < 2; ++n) { const f32x4 v = acc[ai][bj][m][n]; u32x2 w; w.x = pk2(v[0], v[1]); w.y = pk2(v[2], v[3]);
                        *(u32x2*)(Y + (unsigned)(row * 1024 + cb + 128 * bj + 16 * n)) = w; } }
    }
};

struct EpiG {
    static constexpr bool PERM = false, AFTER_DRAIN = false;
    const bf16_t* Y; bf16_t* MG; int first;
    __device__ __forceinline__ void operator()(const f32x4 (&acc)[2][2][4][2], const Unit& u, int wr, int wc, int fr, int fq) const {
        const int row0 = u.pm * 256 + wr * 64 + fr; const int cb = u.pn * 256 + 32 * wc + 4 * fq;
#pragma unroll
        for (int ai = 0; ai < 2; ++ai)
#pragma unroll
            for (int mh = 0; mh < 2; ++mh) {
                u32x2 yv[2][2][2], mv[2][2][2];
#pragma unroll
                for (int mm = 0; mm < 2; ++mm) { const int row = row0 + ai * 128 + (mh * 2 + mm) * 16;
#pragma unroll
                    for (int bj = 0; bj < 2; ++bj)
#pragma unroll
                        for (int n = 0; n < 2; ++n) { const unsigned off = (unsigned)(row * 1024 + cb + 128 * bj + 16 * n);
                            yv[mm][bj][n] = *(const u32x2*)(Y + off); mv[mm][bj][n] = (u32x2){0u, 0u}; if (!first) mv[mm][bj][n] = *(const u32x2*)(MG + off); } }
#pragma unroll
                for (int mm = 0; mm < 2; ++mm) { const int m = mh * 2 + mm; const int row = row0 + ai * 128 + m * 16;
#pragma unroll
                    for (int bj = 0; bj < 2; ++bj)
#pragma unroll
                        for (int n = 0; n < 2; ++n) { const f32x4 g = acc[ai][bj][m][n]; const unsigned off = (unsigned)(row * 1024 + cb + 128 * bj + 16 * n);
                            const u32x2 y = yv[mm][bj][n], mg = mv[mm][bj][n]; u32x2 w;
                            w.x = pk2(bflo(mg.x) + sigmoidf_(g[0]) * bflo(y.x), bfhi(mg.x) + sigmoidf_(g[1]) * bfhi(y.x));
                            w.y = pk2(bflo(mg.y) + sigmoidf_(g[2]) * bflo(y.y), bfhi(mg.y) + sigmoidf_(g[3]) * bfhi(y.y));
                            *(u32x2*)(MG + off) = w; } }
                asm volatile("" ::: "memory");
            }
    }
};

struct EpiOut {
    static constexpr bool PERM = false, AFTER_DRAIN = false;
    const float* xres; float* out;
    __device__ __forceinline__ void operator()(const f32x4 (&acc)[2][2][4][2], const Unit& u, int wr, int wc, int fr, int fq) const {
        const int row0 = u.pm * 256 + wr * 64 + fr; const int cb = u.pn * 256 + 32 * wc + 4 * fq;
#pragma unroll
        for (int ai = 0; ai < 2; ++ai)
#pragma unroll
            for (int mh = 0; mh < 2; ++mh) {
                f32x4 xr[2][2][2];
#pragma unroll
                for (int mm = 0; mm < 2; ++mm) { const int row = row0 + ai * 128 + (mh * 2 + mm) * 16;
#pragma unroll
                    for (int bj = 0; bj < 2; ++bj)
#pragma unroll
                        for (int n = 0; n < 2; ++n) xr[mm][bj][n] = *(const f32x4*)(xres + (unsigned)(row * 1024 + cb + 128 * bj + 16 * n)); }
#pragma unroll
                for (int mm = 0; mm < 2; ++mm) { const int m = mh * 2 + mm; const int row = row0 + ai * 128 + m * 16;
#pragma unroll
                    for (int bj = 0; bj < 2; ++bj)
#pragma unroll
                        for (int n = 0; n < 2; ++n) *(f32x4*)(out + (unsigned)(row * 1024 + cb + 128 * bj + 16 * n)) = xr[mm][bj][n] * ALPHA_RES + acc[ai][bj][m][n]; }
                asm volatile("" ::: "memory");
            }
    }
};

struct EpiAll {
    static constexpr bool PERM = false, AFTER_DRAIN = false;
    Epi1 e1; EpiZ ez; EpiY ey; EpiG eg; EpiOut eo; int mode;
    __device__ __forceinline__ void operator()(const f32x4 (&acc)[2][2][4][2], const Unit& u, int wr, int wc, int fr, int fq) const {
        if (mode == 0) e1(acc, u, wr, wc, fr, fq);
        else if (mode == 1) ez(acc, u, wr, wc, fr, fq);
        else if (mode == 2) ey(acc, u, wr, wc, fr, fq);
        else if (mode == 3) eg(acc, u, wr, wc, fr, fq);
        else if (mode == 4) eo(acc, u, wr, wc, fr, fq);
    }
};

__device__ __forceinline__ int rope_perm(int q) { const int hd = q >> 6, r = q & 63; return hd * 64 + 16 * (r >> 5) + (r & 15) + 32 * ((r >> 4) & 1); }
__device__ __forceinline__ int win_map(int p) {
    if (p < 4096) {
        const int t = p >> 8, q = p & 255;
        if (t < 2) return t * 256 + rope_perm(q);
        if (t < 4) return 512 + (t - 2) * 256 + rope_perm(q);
        if (t < 6) return 1024 + (t - 4) * 256 + q;
        if (t < 8) return 2048 + (t - 6) * 256 + q;
        if (t < 10) return 2560 + (t - 8) * 256 + q;
        if (t < 12) return 3072 + (t - 10) * 256 + q;
        if (t == 12) return q < 128 ? 3584 + q : -1;
        if (t < 15) return 4224 + (t - 13) * 256 + rope_perm(q);
        return q < 128 ? 4736 + rope_perm(q) : 4864 + (q - 128);
    }
    if (p < 5632) { const int q = p - 4096, br = q >> 9, c = q & 511; return br == 0 ? 1536 + c : (br == 1 ? 3712 + c : 4992 + c); }
    return 5504 + (p - 5632);
}
__device__ __forceinline__ void transpose_item(const float* W, int Nsrc, bf16_t* WT, int K, int k0, int p0, int srccol, LAS float* scr, int lane) {
#pragma unroll
    for (int i = 0; i < 8; ++i) { const int kk = 8 * i + (lane >> 3);
        f32x4 v = {0.f, 0.f, 0.f, 0.f}; if (srccol >= 0) v = *(const f32x4*)(W + (size_t)(k0 + kk) * Nsrc + srccol);
        LAS float* d = scr + kk * 33 + 4 * (lane & 7); d[0] = v[0]; d[1] = v[1]; d[2] = v[2]; d[3] = v[3]; }
    LDS_WAIT();
    const int c = lane & 7;
#pragma unroll
    for (int j = 0; j < 4; ++j) { const int n = (lane >> 3) + 8 * j; const LAS float* s = scr + (8 * c) * 33 + n;
        u32x4 o; o.x = pk2(s[0 * 33], s[1 * 33]); o.y = pk2(s[2 * 33], s[3 * 33]); o.z = pk2(s[4 * 33], s[5 * 33]); o.w = pk2(s[6 * 33], s[7 * 33]);
        *(u32x4*)(WT + (size_t)(p0 + n) * K + k0 + 8 * c) = o; }
    LDS_WAIT();
}
__device__ __forceinline__ float wave_sum(float v) {
#pragma unroll
    for (int o = 1; o < 64; o <<= 1) v += __shfl_xor(v, o);
    return v;
}
__device__ __forceinline__ void row_to_bf16(const float* src, float* dst_f32, bf16_t* dst_bf, const float* g, const float* b, bool do_ln, int lane) {
    const f32x4* xr = (const f32x4*)src + lane;
    f32x4 v[4]; float s = 0.f;
#pragma unroll
    for (int j = 0; j < 4; ++j) { v[j] = xr[64 * j]; s += (v[j][0] + v[j][1]) + (v[j][2] + v[j][3]); }
    if (do_ln) {
        const float mean = wave_sum(s) * (1.f / 1024.f); float s2 = 0.f;
#pragma unroll
        for (int j = 0; j < 4; ++j) { v[j] = v[j] - mean; s2 += (v[j][0] * v[j][0] + v[j][1] * v[j][1]) + (v[j][2] * v[j][2] + v[j][3] * v[j][3]); }
        const float rstd = 1.0f / sqrtf(wave_sum(s2) * (1.f / 1024.f) + 1e-5f);
#pragma unroll
        for (int j = 0; j < 4; ++j) { const f32x4 gg = ((const f32x4*)g)[lane + 64 * j], bb = ((const f32x4*)b)[lane + 64 * j]; v[j] = v[j] * rstd * gg + bb; }
        if (dst_f32) {
#pragma unroll
            for (int j = 0; j < 4; ++j) ((f32x4*)dst_f32)[lane + 64 * j] = v[j];
        }
    }
    if (dst_bf) {
#pragma unroll
        for (int j = 0; j < 4; ++j) { u32x2 w; w.x = pk2(v[j][0], v[j][1]); w.y = pk2(v[j][2], v[j][3]); ((u32x2*)dst_bf)[lane + 64 * j] = w; }
    }
}

constexpr int KS_PITCH = 144, VT_PITCH = 72, VT_TILE = 64 * 72;
constexpr int ALDS_K = 0, ALDS_V = 55296, ALDS_KM = 116736, ALDS_SEL = 124672;

template <int MASK, class MaskF>
__device__ __forceinline__ void attn_tile(const LAS unsigned char* Kt, const LAS unsigned char* Vt, const bf16x8 (&qf)[4], float& m, float& l, f32x16& o0, f32x16& o1,
                                          int r32, int hi, bool lane_on, MaskF valid) {
    f32x16 s;
#pragma unroll
    for (int r = 0; r < 16; ++r) s[r] = 0.f;
#pragma unroll
    for (int ks = 0; ks < 4; ++ks) { const bf16x8 a = *(const LAS bf16x8*)(Kt + r32 * KS_PITCH + (ks * 16 + hi * 8) * 2); s = __builtin_amdgcn_mfma_f32_32x32x16_bf16(a, qf[ks], s, 0, 0, 0); }
    if (MASK == 1) {
#pragma unroll
        for (int r = 0; r < 16; ++r) if (!valid(crow(r, hi))) s[r] = NEGF;
    }
    float mx = s[0];
#pragma unroll
    for (int r = 1; r < 16; ++r) mx = fmaxf(mx, s[r]);
    if (MASK == 2) mx = lane_on ? mx : NEGF;
    { const auto rr_ = __builtin_amdgcn_permlane32_swap(__float_as_uint(mx), __float_as_uint(mx), false, false); mx = fmaxf(__uint_as_float(rr_[0]), __uint_as_float(rr_[1])); }
    const float mn = fmaxf(m, mx);
    if (__any(mn > m)) {
        const float alpha = __builtin_amdgcn_exp2f(m - mn); m = mn; l *= alpha;
#pragma unroll
        for (int r = 0; r < 16; ++r) { o0[r] *= alpha; o1[r] *= alpha; }
    }
    float ps = 0.f;
#pragma unroll
    for (int r = 0; r < 16; ++r) { s[r] = __builtin_amdgcn_exp2f(s[r] - mn); ps += s[r]; }
    if (MASK == 2) ps = lane_on ? ps : 0.f;
    l += ps;
#pragma unroll
    for (int s2 = 0; s2 < 2; ++s2) {
        u32x4 pw; pw.x = pk2(s[8 * s2 + 0], s[8 * s2 + 1]); pw.y = pk2(s[8 * s2 + 2], s[8 * s2 + 3]); pw.z = pk2(s[8 * s2 + 4], s[8 * s2 + 5]); pw.w = pk2(s[8 * s2 + 6], s[8 * s2 + 7]);
        if (MASK == 2) { pw.x = lane_on ? pw.x : 0u; pw.y = lane_on ? pw.y : 0u; pw.z = lane_on ? pw.z : 0u; pw.w = lane_on ? pw.w : 0u; }
        const bf16x8 pb = __builtin_bit_cast(bf16x8, pw);
        { const LAS unsigned char* vp = Vt + r32 * VT_PITCH + (16 * s2 + 4 * hi) * 2; const u32x2 lo = *(const LAS u32x2*)vp, hh = *(const LAS u32x2*)(vp + 16);
          u32x4 aw; aw.x = lo.x; aw.y = lo.y; aw.z = hh.x; aw.w = hh.y; o0 = __builtin_amdgcn_mfma_f32_32x32x16_bf16(__builtin_bit_cast(bf16x8, aw), pb, o0, 0, 0, 0); }
        { const LAS unsigned char* vp = Vt + (32 + r32) * VT_PITCH + (16 * s2 + 4 * hi) * 2; const u32x2 lo = *(const LAS u32x2*)vp, hh = *(const LAS u32x2*)(vp + 16);
          u32x4 aw; aw.x = lo.x; aw.y = lo.y; aw.z = hh.x; aw.w = hh.y; o1 = __builtin_amdgcn_mfma_f32_32x32x16_bf16(__builtin_bit_cast(bf16x8, aw), pb, o1, 0, 0, 0); }
    }
}
struct KvRegs { u32x4 k[4], v[4]; };
__device__ __forceinline__ void kv_load256(KvRegs& R, const bf16_t* Ksrc, const bf16_t* Vsrc, int pitch, int tid) {
#pragma unroll
    for (int i = 0; i < 4; ++i) { const int q = tid + NTHR * i; const int key = q >> 3, pc = q & 7; R.k[i] = *(const u32x4*)(Ksrc + (size_t)key * pitch + pc * 8); }
#pragma unroll
    for (int i = 0; i < 4; ++i) { const int q = tid + NTHR * i; const int key = q & 255, pc = q >> 8; R.v[i] = *(const u32x4*)(Vsrc + (size_t)key * pitch + pc * 8); }
}
__device__ __forceinline__ void kv_store256(LAS unsigned char* lds, const KvRegs& R, int tid) {
#pragma unroll
    for (int i = 0; i < 4; ++i) { const int q = tid + NTHR * i; const int key = q >> 3, pc = q & 7; *(LAS u32x4*)(lds + ALDS_K + key * KS_PITCH + pc * 16) = R.k[i]; }
#pragma unroll
    for (int i = 0; i < 4; ++i) { const int q = tid + NTHR * i; const int key = q & 255, pc = q >> 8; const u32x4 vv = R.v[i];
        LAS unsigned short* vt = (LAS unsigned short*)(lds + ALDS_V + (key >> 5) * VT_TILE + (pc * 8) * VT_PITCH + (key & 31) * 2);
        vt[0 * 36] = (unsigned short)(vv.x & 0xffffu); vt[1 * 36] = (unsigned short)(vv.x >> 16);
        vt[2 * 36] = (unsigned short)(vv.y & 0xffffu); vt[3 * 36] = (unsigned short)(vv.y >> 16);
        vt[4 * 36] = (unsigned short)(vv.z & 0xffffu); vt[5 * 36] = (unsigned short)(vv.z >> 16);
        vt[6 * 36] = (unsigned short)(vv.w & 0xffffu); vt[7 * 36] = (unsigned short)(vv.w >> 16); }
}
__device__ __forceinline__ void stage_kv(LAS unsigned char* lds, const bf16_t* Ksrc, const bf16_t* Vsrc, int pitch, int nkeys, int first_valid, int tid) {
    for (int i = tid; i < nkeys * 8; i += NTHR) {
        const int key = i >> 3, pc = i & 7;
        if (key < first_valid) continue;
        const u32x4 kv = *(const u32x4*)(Ksrc + (size_t)key * pitch + pc * 8);
        *(LAS u32x4*)(lds + ALDS_K + key * KS_PITCH + pc * 16) = kv;
    }
    for (int i = tid; i < nkeys * 8; i += NTHR) {
        const int key = i % nkeys, pc = i / nkeys;
        if (key < first_valid) continue;
        const u32x4 vv = *(const u32x4*)(Vsrc + (size_t)key * pitch + pc * 8);
        LAS unsigned short* vt = (LAS unsigned short*)(lds + ALDS_V + (key >> 5) * VT_TILE + (pc * 8) * VT_PITCH + (key & 31) * 2);
        vt[0 * 36] = (unsigned short)(vv.x & 0xffffu); vt[1 * 36] = (unsigned short)(vv.x >> 16);
        vt[2 * 36] = (unsigned short)(vv.y & 0xffffu); vt[3 * 36] = (unsigned short)(vv.y >> 16);
        vt[4 * 36] = (unsigned short)(vv.z & 0xffffu); vt[5 * 36] = (unsigned short)(vv.z >> 16);
        vt[6 * 36] = (unsigned short)(vv.w & 0xffffu); vt[7 * 36] = (unsigned short)(vv.w >> 16);
    }
}
__device__ __forceinline__ void attn_store(bf16_t* O, int pitch, const f32x16& o0, const f32x16& o1, float inv, int hi) {
#pragma unroll
    for (int g = 0; g < 4; ++g) {
        u32x2 w; w.x = pk2(o0[4 * g] * inv, o0[4 * g + 1] * inv); w.y = pk2(o0[4 * g + 2] * inv, o0[4 * g + 3] * inv);
        *(u32x2*)(O + 8 * g + 4 * hi) = w;
        w.x = pk2(o1[4 * g] * inv, o1[4 * g + 1] * inv); w.y = pk2(o1[4 * g + 2] * inv, o1[4 * g + 3] * inv);
        *(u32x2*)(O + 32 + 8 * g + 4 * hi) = w;
    }
}

__device__ __forceinline__ void moba_item(unsigned char* ldsg, LAS unsigned char* lds, const Params& P, int b, int h, int n, bool dry = false) {
    const int tid = tid_l(), lane = tid & 63, r32 = lane & 31, hi = lane >> 5; const int w = __builtin_amdgcn_readfirstlane(tid >> 6);
    bf16_t* QA = (bf16_t*)(wsl(P) + WS_QA); const bf16_t* KA = (const bf16_t*)(wsl(P) + WS_KA); const bf16_t* VA = (const bf16_t*)(wsl(P) + WS_VA);
    const float* KMEAN = (const float*)(wsl(P) + WS_KMEAN);
    const size_t rowbase = (size_t)b * SEQL + (size_t)n * 256;
    LAS float* KM = (LAS float*)(lds + ALDS_KM); LAS int* SEL = (LAS int*)(lds + ALDS_SEL);
    __syncthreads();
    for (int i = tid; i < n * 64; i += NTHR) KM[i] = KMEAN[(size_t)(b * 32 + (i >> 6)) * 512 + h * 64 + (i & 63)];
    __syncthreads();
    if (tid < 256) {
        int mask = 0;
        if (n <= 3) mask = (1 << n) - 1;
        else {
            float q[64];
            const u32x4* qp = (const u32x4*)(QA + (rowbase + tid) * 512 + h * 64);
#pragma unroll
            for (int i = 0; i < 8; ++i) { const u32x4 t = qp[i]; q[8 * i] = bflo(t.x); q[8 * i + 1] = bfhi(t.x); q[8 * i + 2] = bflo(t.y); q[8 * i + 3] = bfhi(t.y); q[8 * i + 4] = bflo(t.z); q[8 * i + 5] = bfhi(t.z); q[8 * i + 6] = bflo(t.w); q[8 * i + 7] = bfhi(t.w); }
            float v1 = -3.0e38f, v2 = -3.0e38f, v3 = -3.0e38f; int i1 = 0, i2 = 0, i3 = 0;
            for (int j = 0; j < n; ++j) {
                float g0 = 0.f, g1 = 0.f, g2 = 0.f, g3 = 0.f;
#pragma unroll
                for (int d = 0; d < 64; d += 4) { const f32x4 kmv = *(const LAS f32x4*)(KM + j * 64 + d); g0 += q[d] * kmv[0]; g1 += q[d + 1] * kmv[1]; g2 += q[d + 2] * kmv[2]; g3 += q[d + 3] * kmv[3]; }
                const float g = (g0 + g1) + (g2 + g3);
                if (g > v1) { v3 = v2; i3 = i2; v2 = v1; i2 = i1; v1 = g; i1 = j; }
                else if (g > v2) { v3 = v2; i3 = i2; v2 = g; i2 = j; }
                else if (g > v3) { v3 = g; i3 = j; }
            }
            mask = (1 << i1) | (1 << i2) | (1 << i3);
        }
        SEL[tid] = mask;
    }
    __syncthreads();
    const int sel = SEL[w * 32 + r32];
    bf16x8 qf[4];
    { const bf16_t* qrow = QA + (rowbase + w * 32 + r32) * 512 + h * 64;
#pragma unroll
      for (int ks = 0; ks < 4; ++ks) qf[ks] = *(const bf16x8*)(qrow + ks * 16 + hi * 8); }
    float m = NEGF, l = 0.f; f32x16 o0, o1;
#pragma unroll
    for (int r = 0; r < 16; ++r) { o0[r] = 0.f; o1[r] = 0.f; }
    const bf16_t* Kb = KA + (size_t)b * SEQL * 512 + h * 64; const bf16_t* Vb = VA + (size_t)b * SEQL * 512 + h * 64;
    KvRegs R;
    kv_load256(R, Kb, Vb, 512, tid);
    for (int j = 0; j <= n; ++j) {
        __syncthreads();
        kv_store256(lds, R, tid);
        __syncthreads();
        if (j < n) kv_load256(R, Kb + (size_t)(j + 1) * 256 * 512, Vb + (size_t)(j + 1) * 256 * 512, 512, tid);
        if (j < n) {
            const bool mine = (sel >> j) & 1;
            if (__any(mine)) {
                for (int t = 0; t < 8; ++t)
                    attn_tile<2>(lds + ALDS_K + t * 32 * KS_PITCH, lds + ALDS_V + t * VT_TILE, qf, m, l, o0, o1, r32, hi, mine, [&](int) { return true; });
            }
        } else {
            for (int t = 0; t < w; ++t)
                attn_tile<0>(lds + ALDS_K + t * 32 * KS_PITCH, lds + ALDS_V + t * VT_TILE, qf, m, l, o0, o1, r32, hi, true, [&](int) { return true; });
            attn_tile<1>(lds + ALDS_K + w * 32 * KS_PITCH, lds + ALDS_V + w * VT_TILE, qf, m, l, o0, o1, r32, hi, true, [&](int kc) { return kc <= r32; });
        }
    }
    float lt; { const auto rr_ = __builtin_amdgcn_permlane32_swap(__float_as_uint(l), __float_as_uint(l), false, false); lt = __uint_as_float(rr_[0]) + __uint_as_float(rr_[1]); }
    if (!dry || lt == 12345.678f) attn_store(QA + (rowbase + w * 32 + r32) * 512 + h * 64, 512, o0, o1, 1.0f / lt, hi);
}

__device__ __forceinline__ void swa_item(LAS unsigned char* lds, const Params& P, int layer, int b, int qh, int blk, bool dry = false) {
    const int tid = tid_l(), lane = tid & 63, r32 = lane & 31, hi = lane >> 5; const int w = __builtin_amdgcn_readfirstlane(tid >> 6);
    bf16_t* QC = (bf16_t*)(wsl(P) + WS_QC); const bf16_t* KC = (const bf16_t*)(wsl(P) + WS_MISC); const bf16_t* VC = KC + 128;
    const int Q0 = blk * 256, kvh = qh >> 2;
    const size_t rowq = (size_t)b * SEQL + Q0 + w * 32 + r32;
    bf16x8 qf[4];
    { const bf16_t* qrow = QC + rowq * 512 + qh * 64;
#pragma unroll
      for (int ks = 0; ks < 4; ++ks) qf[ks] = *(const bf16x8*)(qrow + ks * 16 + hi * 8); }
    __syncthreads();
    const long kbase = (long)b * SEQL + Q0 - 128;
    stage_kv(lds, KC + kbase * 512 + kvh * 64, VC + kbase * 512 + kvh * 64, 512, 384, blk == 0 ? 128 : 0, tid);
    __syncthreads();
    float m = NEGF, l = 0.f; f32x16 o0, o1;
#pragma unroll
    for (int r = 0; r < 16; ++r) { o0[r] = 0.f; o1[r] = 0.f; }
    for (int tt = w; tt <= w + 4; ++tt) {
        if (blk == 0 && tt < 4) continue;
        if (tt == w) attn_tile<1>(lds + ALDS_K + tt * 32 * KS_PITCH, lds + ALDS_V + tt * VT_TILE, qf, m, l, o0, o1, r32, hi, true, [&](int kc) { return kc > r32; });
        else if (tt == w + 4) attn_tile<1>(lds + ALDS_K + tt * 32 * KS_PITCH, lds + ALDS_V + tt * VT_TILE, qf, m, l, o0, o1, r32, hi, true, [&](int kc) { return kc <= r32; });
        else attn_tile<0>(lds + ALDS_K + tt * 32 * KS_PITCH, lds + ALDS_V + tt * VT_TILE, qf, m, l, o0, o1, r32, hi, true, [&](int) { return true; });
    }
    const float sk = P.sinks[layer * 8 + qh] * LOG2E;
    const float mn = fmaxf(m, sk); const float alpha = __builtin_amdgcn_exp2f(m - mn);
    float lsum; { const auto rr_ = __builtin_amdgcn_permlane32_swap(__float_as_uint(l), __float_as_uint(l), false, false); lsum = __uint_as_float(rr_[0]) + __uint_as_float(rr_[1]); }
    const float lt = lsum * alpha + __builtin_amdgcn_exp2f(sk - mn);
    if (!dry || lt == 12345.678f) attn_store(QC + rowq * 512 + qh * 64, 512, o0, o1, alpha / lt, hi);
}

constexpr int MP = 72;
__device__ __forceinline__ f32x4 mm_tile(const LAS bf16_t* X, const LAS bf16_t* Y, int ti, int tj, int m, int g, f32x4 acc) {
#pragma unroll
    for (int ks = 0; ks < 2; ++ks) {
        const bf16x8 a = *(const LAS bf16x8*)(X + (16 * ti + m) * MP + ks * 32 + g * 8);
        const bf16x8 b = *(const LAS bf16x8*)(Y + (16 * tj + m) * MP + ks * 32 + g * 8);
        acc = __builtin_amdgcn_mfma_f32_16x16x32_bf16(a, b, acc, 0, 0, 0);
    }
    return acc;
}
struct PreRaw { u32x4 rc, kc, vc, lc0, lc1, rp, kp, vp, lp0, lp1; };
__device__ __forceinline__ void prepass_load(PreRaw& R, const Params& P, int T, int h, int tid) {
    unsigned char* ws = wsl(P);
    const bf16_t* RB = (const bf16_t*)(ws + WS_RB); const bf16_t* KB = (const bf16_t*)(ws + WS_KB); const bf16_t* VB = (const bf16_t*)(ws + WS_VB);
    const bf16_t* LORA = (const bf16_t*)(ws + WS_MISC) + 256; const bf16_t* BND = (const bf16_t*)(ws + WS_BND);
    const int tok = tid >> 3, c8 = tid & 7; const unsigned row = (unsigned)(T * 64 + tok); const int ch = h * 64 + c8 * 8;
    R.rc = *(const u32x4*)(RB + row * 512u + ch); R.kc = *(const u32x4*)(KB + row * 512u + ch); R.vc = *(const u32x4*)(VB + row * 512u + ch);
    R.lc0 = *(const u32x4*)(LORA + row * 512u + c8 * 16); R.lc1 = *(const u32x4*)(LORA + row * 512u + c8 * 16 + 8);
    const u32x4 z = {0u, 0u, 0u, 0u}; R.rp = z; R.kp = z; R.vp = z; R.lp0 = z; R.lp1 = z;
    if ((row & (SEQL - 1)) != 0) {
        if (tok == 0) { const bf16_t* bp = BND + (unsigned)(T - 1) * 1664u;
            R.rp = *(const u32x4*)(bp + ch); R.kp = *(const u32x4*)(bp + 512 + ch); R.vp = *(const u32x4*)(bp + 1024 + ch); R.lp0 = *(const u32x4*)(bp + 1536 + c8 * 16); R.lp1 = *(const u32x4*)(bp + 1536 + c8 * 16 + 8); }
        else { R.rp = *(const u32x4*)(RB + (row - 1) * 512u + ch); R.kp = *(const u32x4*)(KB + (row - 1) * 512u + ch); R.vp = *(const u32x4*)(VB + (row - 1) * 512u + ch);
            R.lp0 = *(const u32x4*)(LORA + (row - 1) * 512u + c8 * 16); R.lp1 = *(const u32x4*)(LORA + (row - 1) * 512u + c8 * 16 + 8); }
    }
}
__device__ __forceinline__ void rwkv_prepass_head(LAS unsigned char* lds, const Params& P, int layer, int h, int T0, int Tstep, int Tend) {
    const int tid = tid_l(), tok = tid >> 3, c8 = tid & 7;
    unsigned char* ws = wsl(P);
    bf16_t* RB = (bf16_t*)(ws + WS_RB); bf16_t* KB = (bf16_t*)(ws + WS_KB); bf16_t* VB = (bf16_t*)(ws + WS_VB);
    bf16_t* DW = (bf16_t*)(ws + WS_DW); bf16_t* KK = (bf16_t*)(ws + WS_KK); bf16_t* BB = (bf16_t*)(ws + WS_BB); float* RK = (float*)(ws + WS_RK);
    const float* mu = P.mu + layer * 2176;
    LAS bf16_t* Lw = (LAS bf16_t*)lds;
    LAS bf16_t* La = (LAS bf16_t*)(lds + 9216);
    LAS bf16_t* WUt = (LAS bf16_t*)(lds + 18432);
    LAS bf16_t* AUt = (LAS bf16_t*)(lds + 27648);
    LAS float* OW = (LAS float*)(lds + 36864);
    LAS float* OA = (LAS float*)(lds + 54272);
    LAS float* PRM = (LAS float*)(lds + 71680);
    const int lane_ = tid & 63, wv_ = tid >> 6, m16 = lane_ & 15, g4 = lane_ >> 4;
    const int ch = h * 64 + c8 * 8;
    if (T0 >= Tend) return;
    __syncthreads();
    for (int i = tid; i < 4096; i += NTHR) { const int j = i >> 6, cc = i & 63; const size_t so = (size_t)layer * 64 * 512 + (size_t)j * 512 + h * 64 + cc;
        WUt[cc * MP + j] = (bf16_t)(pk2(P.w_up[so], 0.f) & 0xffffu); AUt[cc * MP + j] = (bf16_t)(pk2(P.a_up[so], 0.f) & 0xffffu); }
    if (tid < 64) { const int cc = h * 64 + tid;
        PRM[0 * 64 + tid] = P.w0[layer * 512 + cc]; PRM[1 * 64 + tid] = P.a0[layer * 512 + cc]; PRM[2 * 64 + tid] = P.k_k[layer * 512 + cc]; PRM[3 * 64 + tid] = P.k_a[layer * 512 + cc];
        PRM[4 * 64 + tid] = P.r_k[layer * 512 + cc]; PRM[5 * 64 + tid] = mu[cc]; PRM[6 * 64 + tid] = mu[512 + cc]; PRM[7 * 64 + tid] = mu[1024 + cc]; }
    if (tid >= 64 && tid < 192) PRM[512 + tid - 64] = mu[1536 + tid - 64];
    PreRaw R; prepass_load(R, P, T0, h, tid);
    for (int T = T0; T < Tend; T += Tstep) {
        const unsigned row = (unsigned)(T * 64 + tok);
        __syncthreads();
        {
            const unsigned cw[8] = {R.lc0.x, R.lc0.y, R.lc0.z, R.lc0.w, R.lc1.x, R.lc1.y, R.lc1.z, R.lc1.w}; const unsigned pw[8] = {R.lp0.x, R.lp0.y, R.lp0.z, R.lp0.w, R.lp1.x, R.lp1.y, R.lp1.z, R.lp1.w};
            unsigned pkd[8];
#pragma unroll
            for (int i = 0; i < 8; ++i) {
                const int col = c8 * 16 + 2 * i;
                const float m0 = PRM[512 + col], m1 = PRM[512 + col + 1];
                float a = bflo(cw[i]), bq = bfhi(cw[i]); a = a + (bflo(pw[i]) - a) * m0; bq = bq + (bfhi(pw[i]) - bq) * m1;
                if (col < 64) { a = 1.0f - 2.0f * __builtin_amdgcn_rcpf(1.0f + __expf(2.0f * a)); bq = 1.0f - 2.0f * __builtin_amdgcn_rcpf(1.0f + __expf(2.0f * bq)); }
                pkd[i] = pk2(a, bq);
            }
            LAS bf16_t* dstl = (c8 < 4 ? Lw : La) + tok * MP + (c8 & 3) * 16;
            *(LAS u32x4*)dstl = (u32x4){pkd[0], pkd[1], pkd[2], pkd[3]}; *(LAS u32x4*)(dstl + 8) = (u32x4){pkd[4], pkd[5], pkd[6], pkd[7]};
        }
        const PreRaw C = R;
        __syncthreads();
        if (T + Tstep < Tend) prepass_load(R, P, T + Tstep, h, tid);
#pragma unroll
        for (int q = 0; q < 2; ++q) { const int id = 2 * wv_ + q, ti = id >> 2, tj = id & 3; const f32x4 z4 = {0.f, 0.f, 0.f, 0.f};
            const f32x4 dw_ = mm_tile(Lw, WUt, ti, tj, m16, g4, z4), da_ = mm_tile(La, AUt, ti, tj, m16, g4, z4);
#pragma unroll
            for (int e = 0; e < 4; ++e) { OW[(16 * ti + 4 * g4 + e) * 68 + 16 * tj + m16] = dw_[e]; OA[(16 * ti + 4 * g4 + e) * 68 + 16 * tj + m16] = da_[e]; } }
        __syncthreads();
        float aw[8], aa[8];
        { const f32x4 w0v = *(const LAS f32x4*)(OW + tok * 68 + c8 * 8), w1v = *(const LAS f32x4*)(OW + tok * 68 + c8 * 8 + 4), a0v = *(const LAS f32x4*)(OA + tok * 68 + c8 * 8), a1v = *(const LAS f32x4*)(OA + tok * 68 + c8 * 8 + 4);
#pragma unroll
          for (int i = 0; i < 4; ++i) { aw[i] = w0v[i]; aw[4 + i] = w1v[i]; aa[i] = a0v[i]; aa[4 + i] = a1v[i]; } }
        const unsigned rcw[4] = {C.rc.x, C.rc.y, C.rc.z, C.rc.w}, rpw[4] = {C.rp.x, C.rp.y, C.rp.z, C.rp.w}, kcw[4] = {C.kc.x, C.kc.y, C.kc.z, C.kc.w}, kpw[4] = {C.kp.x, C.kp.y, C.kp.z, C.kp.w}, vcw[4] = {C.vc.x, C.vc.y, C.vc.z, C.vc.w}, vpw[4] = {C.vp.x, C.vp.y, C.vp.z, C.vp.w};
        float rs[8], ks[8], vs[8], kkr[8], av[8], dw[8];
        float ss = 0.f;
#pragma unroll
        for (int i = 0; i < 8; ++i) {
            const int cl = c8 * 8 + i; const int wi = i >> 1; const bool hiw = i & 1;
            const float r0 = hiw ? bfhi(rcw[wi]) : bflo(rcw[wi]), r1 = hiw ? bfhi(rpw[wi]) : bflo(rpw[wi]);
            const float k0 = hiw ? bfhi(kcw[wi]) : bflo(kcw[wi]), k1 = hiw ? bfhi(kpw[wi]) : bflo(kpw[wi]);
            const float v0 = hiw ? bfhi(vcw[wi]) : bflo(vcw[wi]), v1 = hiw ? bfhi(vpw[wi]) : bflo(vpw[wi]);
            rs[i] = r0 + (r1 - r0) * PRM[5 * 64 + cl]; ks[i] = k0 + (k1 - k0) * PRM[6 * 64 + cl]; vs[i] = v0 + (v1 - v0) * PRM[7 * 64 + cl];
            const float sg = sigmoidf_(PRM[0 * 64 + cl] + aw[i]);
            dw[i] = 1.0f - __expf(-0.6065306597126334f * sg);
            av[i] = sigmoidf_(PRM[1 * 64 + cl] + aa[i]);
            kkr[i] = ks[i] * PRM[2 * 64 + cl]; ss += kkr[i] * kkr[i];
        }
        ss += __shfl_xor(ss, 1); ss += __shfl_xor(ss, 2); ss += __shfl_xor(ss, 4);
        const float inv = 1.0f / fmaxf(sqrtf(ss), 1e-12f);
        float kq[8], kkn[8], bbv[8]; float rk = 0.f;
#pragma unroll
        for (int i = 0; i < 8; ++i) { const int cl = c8 * 8 + i; kkn[i] = kkr[i] * inv; kq[i] = ks[i] * (1.0f + (av[i] - 1.0f) * PRM[3 * 64 + cl]); bbv[i] = kkn[i] * av[i]; rk += rs[i] * kq[i] * PRM[4 * 64 + cl]; }
        rk += __shfl_xor(rk, 1); rk += __shfl_xor(rk, 2); rk += __shfl_xor(rk, 4);
        if (c8 == 0) RK[row * 8u + h] = rk;
        u32x4 o; const unsigned off = row * 512u + ch;
        o.x = pk2(rs[0], rs[1]); o.y = pk2(rs[2], rs[3]); o.z = pk2(rs[4], rs[5]); o.w = pk2(rs[6], rs[7]); *(u32x4*)(RB + off) = o;
        o.x = pk2(kq[0], kq[1]); o.y = pk2(kq[2], kq[3]); o.z = pk2(kq[4], kq[5]); o.w = pk2(kq[6], kq[7]); *(u32x4*)(KB + off) = o;
        o.x = pk2(vs[0], vs[1]); o.y = pk2(vs[2], vs[3]); o.z = pk2(vs[4], vs[5]); o.w = pk2(vs[6], vs[7]); *(u32x4*)(VB + off) = o;
        o.x = pk2(dw[0], dw[1]); o.y = pk2(dw[2], dw[3]); o.z = pk2(dw[4], dw[5]); o.w = pk2(dw[6], dw[7]); *(u32x4*)(DW + off) = o;
        o.x = pk2(kkn[0], kkn[1]); o.y = pk2(kkn[2], kkn[3]); o.z = pk2(kkn[4], kkn[5]); o.w = pk2(kkn[6], kkn[7]); *(u32x4*)(KK + off) = o;
        o.x = pk2(bbv[0], bbv[1]); o.y = pk2(bbv[2], bbv[3]); o.z = pk2(bbv[4], bbv[5]); o.w = pk2(bbv[6], bbv[7]); *(u32x4*)(BB + off) = o;
    }
}

constexpr int NCH = 8, LCH = SEQL / NCH;
constexpr int SC_T = 32, SC_ARR = SC_T * 64 * 4, SC_SCAL = 6 * SC_ARR, SC_BUF = 6 * SC_ARR + 512, SC_Y = 2 * SC_BUF, SC_ROW = SC_Y + 4096;
template <int CTRL> __device__ __forceinline__ float dpp_mov(float v) { return __builtin_bit_cast(float, __builtin_amdgcn_update_dpp(0, __builtin_bit_cast(int, v), CTRL, 0xF, 0xF, true)); }
__device__ __forceinline__ float red8(float v) { v += dpp_mov<0xB1>(v); v += dpp_mov<0x4E>(v); v += dpp_mov<0x141>(v); return v; }
typedef float f32x2 __attribute__((ext_vector_type(2)));
__device__ __forceinline__ void rwkv_scan_task(LAS unsigned char* lds, const Params& P, int bh, int c, int kind  ) {
    const int tid = tid_l(), lane = tid & 63, p = lane & 7; const int w = tid >> 6; const int irow0 = (w & 3) * 16 + (lane >> 3) * 2;
    const bool cw = (w < 4);
    unsigned char* ws = wsl(P);
    const bf16_t* DWp = (const bf16_t*)(ws + WS_DW); const bf16_t* KKp = (const bf16_t*)(ws + WS_KK); const bf16_t* BBp = (const bf16_t*)(ws + WS_BB);
    const bf16_t* KBp = (const bf16_t*)(ws + WS_KB); const bf16_t* RBp = (const bf16_t*)(ws + WS_RB); const bf16_t* VBp = (const bf16_t*)(ws + WS_VB);
    bf16_t* OB = (bf16_t*)(ws + WS_OB); float* PL = (float*)(ws + WS_MISC);
    const int b = bh >> 3, h = bh & 7; const unsigned row0 = (unsigned)(b * SEQL + c * LCH); const int hc = h * 64;
    const bool use_v = (kind != 1);
    f32x2 s[2][4];
#pragma unroll
    for (int r = 0; r < 2; ++r)
#pragma unroll
        for (int i = 0; i < 4; ++i) { s[r][i].x = (kind == 1 && (8 * p + 2 * i) == irow0 + r) ? 1.f : 0.f; s[r][i].y = (kind == 1 && (8 * p + 2 * i + 1) == irow0 + r) ? 1.f : 0.f; }
    __syncthreads();
    if (kind == 2 && c > 0) {
        if (cw) {
#pragma unroll
            for (int r = 0; r < 2; ++r) { const float* L0 = PL + (size_t)((bh * NCH + 0) * 2 + 0) * 4096 + (irow0 + r) * 64 + 8 * p; const f32x4 a = *(const f32x4*)L0, d = *(const f32x4*)(L0 + 4);
              s[r][0] = (f32x2){a[0], a[1]}; s[r][1] = (f32x2){a[2], a[3]}; s[r][2] = (f32x2){d[0], d[1]}; s[r][3] = (f32x2){d[2], d[3]}; }
        }
        LAS float* rowbuf = (LAS float*)(lds + SC_ROW) + irow0 * 64;
        LAS float* Pl = (LAS float*)lds;
        for (int cc = 1; cc < c; ++cc) {
            const float* Pm = PL + (size_t)((bh * NCH + cc) * 2 + 1) * 4096; const float* Lm = PL + (size_t)((bh * NCH + cc) * 2 + 0) * 4096 + irow0 * 64 + 8 * p;
            { const f32x4 q0 = *(const f32x4*)(Pm + tid * 8), q1 = *(const f32x4*)(Pm + tid * 8 + 4); *(LAS f32x4*)(Pl + tid * 8) = q0; *(LAS f32x4*)(Pl + tid * 8 + 4) = q1; }
            if (cw) {
#pragma unroll
                for (int r = 0; r < 2; ++r) { *(LAS f32x4*)(rowbuf + r * 64 + 8 * p) = (f32x4){s[r][0].x, s[r][0].y, s[r][1].x, s[r][1].y}; *(LAS f32x4*)(rowbuf + r * 64 + 8 * p + 4) = (f32x4){s[r][2].x, s[r][2].y, s[r][3].x, s[r][3].y}; }
            }
            __syncthreads();
            if (cw) {
                f32x4 n[2][2];
#pragma unroll
                for (int r = 0; r < 2; ++r) { n[r][0] = *(const f32x4*)(Lm + r * 64); n[r][1] = *(const f32x4*)(Lm + r * 64 + 4); }
#pragma unroll 8
                for (int m = 0; m < 64; ++m) { const float s0 = rowbuf[m], s1 = rowbuf[64 + m]; const f32x4 pa = *(const LAS f32x4*)(Pl + m * 64 + 8 * p), pb = *(const LAS f32x4*)(Pl + m * 64 + 8 * p + 4);
                    n[0][0] += s0 * pa; n[0][1] += s0 * pb; n[1][0] += s1 * pa; n[1][1] += s1 * pb; }
#pragma unroll
                for (int r = 0; r < 2; ++r) { s[r][0] = (f32x2){n[r][0][0], n[r][0][1]}; s[r][1] = (f32x2){n[r][0][2], n[r][0][3]}; s[r][2] = (f32x2){n[r][1][0], n[r][1][1]}; s[r][3] = (f32x2){n[r][1][2], n[r][1][3]}; }
            }
            __syncthreads();
        }
    }
    const int pc = tid & 255, lt = pc >> 3, lc8 = pc & 7, half = tid >> 8;
    u32x4 g0, g1, g2, g3;
    auto gload = [&](int tile) {
        const unsigned off = (row0 + (unsigned)(tile * SC_T + lt)) * 512u + (unsigned)(hc + lc8 * 8);
        if (half == 0) { g0 = *(const u32x4*)(DWp + off); g1 = *(const u32x4*)(RBp + off); g2 = *(const u32x4*)(KKp + off); }
        else { g0 = *(const u32x4*)(BBp + off); g1 = *(const u32x4*)(KBp + off); g2 = *(const u32x4*)(RBp + off); g3 = *(const u32x4*)(VBp + off); }
    };
    auto unpack = [&](const u32x4& u, f32x4& a, f32x4& d) { a[0] = bflo(u.x); a[1] = bfhi(u.x); a[2] = bflo(u.y); a[3] = bfhi(u.y); d[0] = bflo(u.z); d[1] = bfhi(u.z); d[2] = bflo(u.w); d[3] = bfhi(u.w); };
    auto lstore = [&](int buf) {
        LAS unsigned char* B = lds + buf * SC_BUF; const int e = (lt * 64 + lc8 * 8) * 4;
        f32x4 a0, a1, b0, b1, c0, c1;
        unpack(g0, a0, a1); unpack(g1, b0, b1); unpack(g2, c0, c1);
        if (half == 0) {
            a0 = 1.0f - a0; a1 = 1.0f - a1;
            *(LAS f32x4*)(B + 0 * SC_ARR + e) = a0; *(LAS f32x4*)(B + 0 * SC_ARR + e + 16) = a1;
            *(LAS f32x4*)(B + 4 * SC_ARR + e) = a0 * b0; *(LAS f32x4*)(B + 4 * SC_ARR + e + 16) = a1 * b1;
            *(LAS f32x4*)(B + 1 * SC_ARR + e) = c0; *(LAS f32x4*)(B + 1 * SC_ARR + e + 16) = c1;
        } else {
            f32x4 d0, d1; unpack(g3, d0, d1);
            *(LAS f32x4*)(B + 2 * SC_ARR + e) = a0; *(LAS f32x4*)(B + 2 * SC_ARR + e + 16) = a1;
            *(LAS f32x4*)(B + 3 * SC_ARR + e) = b0; *(LAS f32x4*)(B + 3 * SC_ARR + e + 16) = b1;
            if (!use_v) { d0 = (f32x4){0.f, 0.f, 0.f, 0.f}; d1 = d0; }
            *(LAS f32x4*)(B + 5 * SC_ARR + e) = d0; *(LAS f32x4*)(B + 5 * SC_ARR + e + 16) = d1;
            const f32x4 x = a0 * c0 + a1 * c1, y = b0 * c0 + b1 * c1;
            float br = (x[0] + x[1]) + (x[2] + x[3]), kr = (y[0] + y[1]) + (y[2] + y[3]);
            br = red8(br); kr = red8(kr);
            if (lc8 == 0) { LAS float* sc = (LAS float*)(B + SC_SCAL); sc[lt * 2] = br; sc[lt * 2 + 1] = kr; }
        }
    };
    gload(0); lstore(0);
    __syncthreads();
    constexpr int NTILE = LCH / SC_T;
    for (int tile = 0; tile < NTILE; ++tile) {
        const int buf = tile & 1;
        if (tile + 1 < NTILE) gload(tile + 1);
        const LAS unsigned char* B = lds + buf * SC_BUF;
        LAS unsigned short* ytile = (LAS unsigned short*)(lds + SC_Y);
        if (cw) {
#define SC_LOAD(S, t_) do { const int e_ = ((t_) * 64 + p * 8) * 4; \
                S##w0 = *(const LAS f32x4*)(B + 0 * SC_ARR + e_); S##w1 = *(const LAS f32x4*)(B + 0 * SC_ARR + e_ + 16); \
                S##q0 = *(const LAS f32x4*)(B + 1 * SC_ARR + e_); S##q1 = *(const LAS f32x4*)(B + 1 * SC_ARR + e_ + 16); \
                S##b0 = *(const LAS f32x4*)(B + 2 * SC_ARR + e_); S##b1 = *(const LAS f32x4*)(B + 2 * SC_ARR + e_ + 16); \
                S##k0 = *(const LAS f32x4*)(B + 3 * SC_ARR + e_); S##k1 = *(const LAS f32x4*)(B + 3 * SC_ARR + e_ + 16); \
                S##x0 = *(const LAS f32x4*)(B + 4 * SC_ARR + e_); S##x1 = *(const LAS f32x4*)(B + 4 * SC_ARR + e_ + 16); \
                S##vv = *(const LAS f32x2*)(B + 5 * SC_ARR + ((t_) * 64 + irow0) * 4); S##sc = *(const LAS f32x2*)(B + SC_SCAL + (t_) * 8); } while (0)
#define SC_STEP(S, t_) do { \
                const f32x2 wv[4] = {{S##w0[0], S##w0[1]}, {S##w0[2], S##w0[3]}, {S##w1[0], S##w1[1]}, {S##w1[2], S##w1[3]}}; \
                const f32x2 qv[4] = {{S##q0[0], S##q0[1]}, {S##q0[2], S##q0[3]}, {S##q1[0], S##q1[1]}, {S##q1[2], S##q1[3]}}; \
                const f32x2 bv[4] = {{S##b0[0], S##b0[1]}, {S##b0[2], S##b0[3]}, {S##b1[0], S##b1[1]}, {S##b1[2], S##b1[3]}}; \
                const f32x2 kv[4] = {{S##k0[0], S##k0[1]}, {S##k0[2], S##k0[3]}, {S##k1[0], S##k1[1]}, {S##k1[2], S##k1[3]}}; \
                const f32x2 xv[4] = {{S##x0[0], S##x0[1]}, {S##x0[2], S##x0[3]}, {S##x1[0], S##x1[1]}, {S##x1[2], S##x1[3]}}; \
                float d1[2], d2[2]; \
                _Pragma("unroll") for (int r = 0; r < 2; ++r) { f32x2 a1 = s[r][0] * qv[0], a2 = s[r][0] * xv[0]; \
                    _Pragma("unroll") for (int i = 1; i < 4; ++i) { a1 += s[r][i] * qv[i]; a2 += s[r][i] * xv[i]; } \
                    d1[r] = a1.x + a1.y; d2[r] = a2.x + a2.y; } \
                d1[0] = red8(d1[0]); d1[1] = red8(d1[1]); d2[0] = red8(d2[0]); d2[1] = red8(d2[1]); \
                _Pragma("unroll") for (int r = 0; r < 2; ++r) { const float sa = -d1[r], v = r == 0 ? S##vv.x : S##vv.y; const f32x2 sa2 = {sa, sa}, v2 = {v, v}; \
                    _Pragma("unroll") for (int i = 0; i < 4; ++i) { f32x2 tq = sa2 * bv[i]; tq += v2 * kv[i]; s[r][i] = s[r][i] * wv[i] + tq; } \
                    if (kind == 2) { const float y = d2[r] + sa * S##sc.x + v * S##sc.y; if (p == 0) ytile[(t_) * 64 + irow0 + r] = (unsigned short)(pk2(y, 0.f) & 0xffffu); } } } while (0)
            f32x4 Aw0, Aw1, Aq0, Aq1, Ab0, Ab1, Ak0, Ak1, Ax0, Ax1; f32x2 Avv, Asc;
            f32x4 Bw0, Bw1, Bq0, Bq1, Bb0, Bb1, Bk0, Bk1, Bx0, Bx1; f32x2 Bvv, Bsc;
            SC_LOAD(A, 0);
            for (int t = 0; t < SC_T; t += 2) {
                SC_LOAD(B, t + 1);
                SC_STEP(A, t);
                if (t + 2 < SC_T) SC_LOAD(A, t + 2);
                SC_STEP(B, t + 1);
            }
#undef SC_LOAD
#undef SC_STEP
        }
        if (tile + 1 < NTILE) lstore(buf ^ 1);
        __syncthreads();
        if (kind == 2 && tid < 256) {
            const int t = tid >> 3, c8 = tid & 7;
            const u32x4 yv = *(const LAS u32x4*)(lds + SC_Y + (t * 64 + c8 * 8) * 2);
            *(u32x4*)(OB + (row0 + (unsigned)(tile * SC_T + t)) * 512u + (unsigned)(hc + c8 * 8)) = yv;
        }
        __syncthreads();
    }
    if (kind != 2 && cw) {
#pragma unroll
        for (int r = 0; r < 2; ++r) { float* dst = PL + (size_t)((bh * NCH + c) * 2 + kind) * 4096 + (irow0 + r) * 64 + 8 * p;
            *(f32x4*)dst = (f32x4){s[r][0].x, s[r][0].y, s[r][1].x, s[r][1].y}; *(f32x4*)(dst + 4) = (f32x4){s[r][2].x, s[r][2].y, s[r][3].x, s[r][3].y}; }
    }
}
__device__ __forceinline__ void rwkv_gn_row(const Params& P, int layer, size_t row, int lane) {
    bf16_t* OB = (bf16_t*)(wsl(P) + WS_OB); const bf16_t* VB = (const bf16_t*)(wsl(P) + WS_VB); const float* RK = (const float*)(wsl(P) + WS_RK);
    const int ch = lane * 8; const int h = lane >> 3;
    const u32x4 yv = *(const u32x4*)(OB + row * 512 + ch), vv = *(const u32x4*)(VB + row * 512 + ch);
    float y[8] = {bflo(yv.x), bfhi(yv.x), bflo(yv.y), bfhi(yv.y), bflo(yv.z), bfhi(yv.z), bflo(yv.w), bfhi(yv.w)};
    const float v[8] = {bflo(vv.x), bfhi(vv.x), bflo(vv.y), bfhi(vv.y), bflo(vv.z), bfhi(vv.z), bflo(vv.w), bfhi(vv.w)};
    float s = 0.f;
#pragma unroll
    for (int i = 0; i < 8; ++i) s += y[i];
    s += __shfl_xor(s, 1); s += __shfl_xor(s, 2); s += __shfl_xor(s, 4);
    const float mean = s * (1.f / 64.f); float q = 0.f;
#pragma unroll
    for (int i = 0; i < 8; ++i) { y[i] -= mean; q += y[i] * y[i]; }
    q += __shfl_xor(q, 1); q += __shfl_xor(q, 2); q += __shfl_xor(q, 4);
    const float rstd = 1.0f / sqrtf(q * (1.f / 64.f) + 64.0f * 1e-5f);
    const float rk = RK[row * 8 + h];
    const bf16_t* ZB = (const bf16_t*)(wsl(P) + WS_DW);
    const u32x4 zc = *(const u32x4*)(ZB + row * 512 + ch); u32x4 zp = {0u, 0u, 0u, 0u};
    if ((row & (SEQL - 1)) != 0) zp = *(const u32x4*)(ZB + (row - 1) * 512 + ch);
    const float z0[8] = {bflo(zc.x), bfhi(zc.x), bflo(zc.y), bfhi(zc.y), bflo(zc.z), bfhi(zc.z), bflo(zc.w), bfhi(zc.w)};
    const float z1[8] = {bflo(zp.x), bfhi(zp.x), bflo(zp.y), bfhi(zp.y), bflo(zp.z), bfhi(zp.z), bflo(zp.w), bfhi(zp.w)};
    float o[8];
    const f32x4 mu0 = *(const f32x4*)(P.mu + layer * 2176 + 1664 + ch), mu1 = *(const f32x4*)(P.mu + layer * 2176 + 1664 + ch + 4);
    const f32x4 gg0 = *(const f32x4*)(P.gn_g + layer * 512 + ch), gg1 = *(const f32x4*)(P.gn_g + layer * 512 + ch + 4), gb0 = *(const f32x4*)(P.gn_b + layer * 512 + ch), gb1 = *(const f32x4*)(P.gn_b + layer * 512 + ch + 4);
#pragma unroll
    for (int i = 0; i < 8; ++i) { const float muv = i < 4 ? mu0[i & 3] : mu1[i & 3], ggv = i < 4 ? gg0[i & 3] : gg1[i & 3], gbv = i < 4 ? gb0[i & 3] : gb1[i & 3];
        const float z = z0[i] + (z1[i] - z0[i]) * muv;
        o[i] = (y[i] * rstd * ggv + gbv + rk * v[i]) * z * sigmoidf_(z); }
    u32x4 ov; ov.x = pk2(o[0], o[1]); ov.y = pk2(o[2], o[3]); ov.z = pk2(o[4], o[5]); ov.w = pk2(o[6], o[7]);
    *(u32x4*)(OB + row * 512 + ch) = ov;
}

#define XB_TMO      128
#define XB_XCNT(j)  (256  + 64 * (j))
#define XB_XSUB(j)  (1280 + 64 * (j))
#define XB_XGEN(j)  (2304 + 64 * (j))
#define XB_TOP      3328
#define XB_TOPGEN   3392
#define XCD_BAR_WORDS 3456
#define XB_SPIN_CAP (1u << 18)

__device__ __forceinline__ unsigned xb_ld(unsigned* p)              { return __hip_atomic_load(p, __ATOMIC_RELAXED, __HIP_MEMORY_SCOPE_AGENT); }
__device__ __forceinline__ unsigned xb_add(unsigned* p, unsigned v) { return __hip_atomic_fetch_add(p, v, __ATOMIC_RELAXED, __HIP_MEMORY_SCOPE_AGENT); }
__device__ __forceinline__ unsigned xb_xcc_id() { return (unsigned)__builtin_amdgcn_s_getreg((3 << 11) | 20) & 0xFu; }
#define XB_SPIN(cond, bar) do { unsigned _sp = 0; while (cond) { __builtin_amdgcn_s_sleep(1); \
    if ((++_sp & 255u) == 0u) { if (xb_ld(&(bar)[XB_TMO])) break; if (_sp > XB_SPIN_CAP) { atomicAdd(&(bar)[XB_TMO], 1u); break; } } } } while (0)

struct XcdBarrier {
    unsigned* bar; unsigned x;
    volatile LAS unsigned* st;
};

__device__ __forceinline__ XcdBarrier xcd_barrier_post(unsigned* bar, volatile LAS unsigned* st) {
    XcdBarrier b; b.bar = bar; b.x = xb_xcc_id(); b.st = st;
    if (threadIdx.x == 0) (void)xb_add(&bar[XB_XCNT(b.x)], 1u);
    return b;
}
__device__ __forceinline__ void xcd_barrier_complete(unsigned* bar, unsigned x, unsigned& nloc, unsigned& nx) {
    const unsigned G = gridDim.x * gridDim.y * gridDim.z;
    unsigned sum, cnt, mine, sp = 0u;
    for (;;) {
        sum = 0u; cnt = 0u; mine = 0u;
#pragma unroll
        for (unsigned j = 0; j < 16; ++j) { const unsigned c = xb_ld(&bar[XB_XCNT(j)]); sum += c; cnt += (c > 0u) ? 1u : 0u; mine = (j == x) ? c : mine; }
        if (sum == G) break;
        __builtin_amdgcn_s_sleep(1);
        if ((++sp & 255u) == 0u) { if (xb_ld(&bar[XB_TMO])) break; if (sp > XB_SPIN_CAP) { atomicAdd(&bar[XB_TMO], 1u); break; } }
    }
    nloc = mine > 0u ? mine : 1u; nx = cnt > 0u ? cnt : 1u;
}

__device__ __forceinline__ void xcd_barrier(const XcdBarrier& b) {
    asm volatile("s_waitcnt vmcnt(0)" ::: "memory");
    __syncthreads();
    if (threadIdx.x == 0) {
        unsigned* bar = b.bar;
        __builtin_amdgcn_s_waitcnt(0);
        unsigned nloc = b.st[0], nx = b.st[1];
        if (nloc == 0u) { xcd_barrier_complete(bar, b.x, nloc, nx); b.st[0] = nloc; b.st[1] = nx; }
        const unsigned old = xb_add(&bar[XB_XSUB(b.x)], 1u);
        const unsigned gen = old / nloc;
        if (old + 1u == (gen + 1u) * nloc) {
            __builtin_amdgcn_fence(__ATOMIC_RELEASE, "agent");
            asm volatile("s_waitcnt vmcnt(0)" ::: "memory");
            const unsigned og = xb_add(&bar[XB_TOP], 1u);
            const unsigned tg = og / nx;
            if (og + 1u == (tg + 1u) * nx) xb_add(&bar[XB_TOPGEN], 1u);
            else XB_SPIN(xb_ld(&bar[XB_TOPGEN]) == tg, bar);
            __builtin_amdgcn_fence(__ATOMIC_ACQUIRE, "agent");
            xb_add(&bar[XB_XGEN(b.x)], 1u);
            asm volatile("s_waitcnt vmcnt(0)" ::: "memory");
        } else {
            XB_SPIN(xb_ld(&bar[XB_XGEN(b.x)]) == gen, bar);
            __builtin_amdgcn_fence(__ATOMIC_ACQUIRE, "agent");
            asm volatile("s_waitcnt vmcnt(0)" ::: "memory");
        }
    }
    __syncthreads();
}

__global__ void __launch_bounds__(NTHR, 2) hybrid_fwd(Params P) {
    extern __shared__ __attribute__((aligned(16))) unsigned char lds_raw[];
    LAS unsigned char* lds = (LAS unsigned char*)lds_raw;
    cg::grid_group grid = cg::this_grid();
    LAS int* qslot = (LAS int*)(lds + 147440);
    volatile LAS unsigned* xst = (volatile LAS unsigned*)(lds + 147424);
    if (threadIdx.x < 2) xst[threadIdx.x] = 0u;
    __syncthreads();
    const XcdBarrier xbar = xcd_barrier_post((unsigned*)(P.ws + WS_CTL) + 4096, xst);

#ifdef PROBE_A_LO
    LAS unsigned long long* tsv = (LAS unsigned long long*)(lds + 147200);
    if (blockIdx.x == 0 && threadIdx.x == 0) tsv[0] = __builtin_amdgcn_s_memrealtime();
#endif
    for (int gs = 0; gs < NLAYER * 14; ++gs) {
        const int layer = gs / 14, st = gs % 14;
        int G = gridDim.x; asm volatile("" : "+s"(G)); const int NGW = G * 8;
        const int tid = tid_l(), lane = tid & 63; const int wave = __builtin_amdgcn_readfirstlane(tid >> 6); const int gw = blockIdx.x * 8 + wave;
        unsigned char* wsb = wsl(P);
        unsigned* ctl = (unsigned*)(wsb + WS_CTL);
        bf16_t* XB = (bf16_t*)(wsb + WS_XB); bf16_t* WIN = (bf16_t*)(wsb + WS_WIN); bf16_t* WBR = (bf16_t*)(wsb + WS_WBR); bf16_t* WOUT = (bf16_t*)(wsb + WS_WOUT);
        float* cosT = (float*)(wsb + WS_COS); float* sinT = (float*)(wsb + WS_SIN); float* KMEAN = (float*)(wsb + WS_KMEAN);
        const bool is_gemm = (st == 1 || st == 5 || st >= 7);
        if (is_gemm) {
            const bf16_t* A = XB; const bf16_t* Bt = WIN; int N = 1024, K = 1024, mode = 0, br = 0;
            if (st == 1) { N = 4096; }
            else if (st == 5) { Bt = WIN + (size_t)4096 * 1024; N = 1536; mode = 1; }
            else if (st == 13) { A = (const bf16_t*)(wsl(P) + WS_MERGED); Bt = WOUT; mode = 4; }
            else { br = (st - 7) >> 1;
                if (((st - 7) & 1) == 0) { A = (const bf16_t*)(wsl(P) + (br == 0 ? WS_QA : (br == 1 ? WS_OB : WS_QC))); Bt = WBR + (size_t)br * 1024 * 512; K = 512; mode = 2; }
                else { Bt = WIN + (size_t)(5632 + br * 1024) * 1024; mode = 3; } }
            pg8::Gemm g{A, Bt, MTOK, N, K}; pg8::StaticOrder S; S.init(MTOK, N, G, (int)blockIdx.x);
            EpiAll E{Epi1{wsl(P)}, EpiZ{wsl(P)}, EpiY{(bf16_t*)(wsl(P) + WS_Y)}, EpiG{(const bf16_t*)(wsl(P) + WS_Y), (bf16_t*)(wsl(P) + WS_MERGED), br == 0 ? 1 : 0}, EpiOut{layer == 0 ? P.x : (const float*)P.out, P.out}, mode};
            pg8::gemm_phase<EpiAll, pg8::StaticOrder, true, true>(lds, g, S, E);
            __syncthreads();
#ifdef PROBE_DBL_GEMM1
            if (st == 1) { grid.sync(); pg8::gemm_phase<EpiAll, pg8::StaticOrder, true, true>(lds, g, S, E); __syncthreads(); }
#endif
#ifdef PROBE_GEMM1_NOEPI
            if (st == 1) { xcd_barrier(xbar); EpiAll E2 = E; { int m99 = 99; asm volatile("" : "+s"(m99)); E2.mode = m99; } pg8::gemm_phase<EpiAll, pg8::StaticOrder, true, true>(lds, g, S, E2); __syncthreads(); }
#endif
        } else if (st == 0) {
#ifdef PROBE_SYNC10
            for (int r = 0; r < 10; ++r) grid.sync();
#endif
#ifdef PROBE_DBL_P0
            for (int rep = 0; rep < (layer == 0 ? 2 : 1); ++rep) {
#else
            {
#endif
            LAS float* scr = (LAS float*)(lds + wave * 16384);
            constexpr int I_IN = 16 * 272, I_BR = 8 * 32, I_OUT = 16 * 32, NIT = I_IN + 3 * I_BR + I_OUT;
            for (int it = gw; it < NIT; it += NGW) {
                int r = it;
                if (r < I_IN) { const int kb = r / 272, nb = r % 272; transpose_item(P.w_in + (size_t)layer * DM * INW, INW, WIN, 1024, kb * 64, nb * 32, win_map(nb * 32 + 4 * (lane & 7)), scr, lane); continue; }
                r -= I_IN;
                if (r < 3 * I_BR) { const int br = r / I_BR, q = r % I_BR, kb = q / 32, nb = q % 32; const float* W = (br == 0 ? P.wba : br == 1 ? P.wbb : P.wbc) + (size_t)layer * 512 * 1024;
                    transpose_item(W, 1024, WBR + (size_t)br * 1024 * 512, 512, kb * 64, nb * 32, nb * 32 + 4 * (lane & 7), scr, lane); continue; }
                r -= 3 * I_BR;
                { const int kb = r / 32, nb = r % 32; transpose_item(P.w_out + (size_t)layer * 1024 * 1024, 1024, WOUT, 1024, kb * 64, nb * 32, nb * 32 + 4 * (lane & 7), scr, lane); }
            }
            for (int m = gw; m < MTOK; m += NGW) {
                if (layer == 0) row_to_bf16(P.x + (size_t)m * DM, nullptr, XB + (size_t)m * DM, nullptr, nullptr, false, lane);
                else row_to_bf16(P.out + (size_t)m * DM, P.out + (size_t)m * DM, XB + (size_t)m * DM, P.ln_g + (layer - 1) * DM, P.ln_b + (layer - 1) * DM, true, lane);
            }
            if (layer == 0) {
                for (int i = blockIdx.x * NTHR + tid; i < MTOK * 32; i += G * NTHR) { const int m = i >> 5, f = i & 31;
                    const float inv = powf(10000.0f, -(float)f / 32.0f); const float ang = (float)P.pos[m] * inv; cosT[i] = cosf(ang); sinT[i] = sinf(ang); }
            }
            for (int i = blockIdx.x * NTHR + tid; i < 64 * 512; i += G * NTHR) KMEAN[i] = 0.f;
            }
        } else if (st == 2) {
            rwkv_prepass_head(lds, P, layer, (int)blockIdx.x & 7, (int)blockIdx.x >> 3, G >> 3, MTOK / 64);
            for (int it = blockIdx.x; it < 512; it += G) { const int b = it >> 8, qh = (it >> 5) & 7, blk = it & 31; swa_item(lds, P, layer, b, qh, blk); }
        } else if (st == 3) {
#ifdef PROBE_DBL_A
            for (int rep = 0; rep < 2; ++rep)
#endif
            for (int t = blockIdx.x; t < 16 * 13; t += G) {
                if (t < 16 * 7) rwkv_scan_task(lds, P, t / 7, t % 7, 0);
                else { const int q = t - 16 * 7; rwkv_scan_task(lds, P, q / 6, 1 + q % 6, 1); }
            }
        } else if (st == 4) {
#ifdef PROBE_DBL_C
            for (int rep = 0; rep < 2; ++rep)
#endif
            for (int t = blockIdx.x; t < 16 * NCH; t += G) rwkv_scan_task(lds, P, t >> 3, t & 7, 2);
            unsigned* ctr = ctl + 64 * (2 + layer * 4);
            for (;;) {
                __syncthreads();
                if (tid == 0) *qslot = (int)atomicAdd(ctr, 1u);
                __syncthreads();
                const int it = *qslot;
                if (it >= 512) break;
                const int n = 31 - (it >> 4), bh = it & 15;
                moba_item(lds_raw, lds, P, bh >> 3, bh & 7, n);
            }
        } else {
            for (int m = gw; m < MTOK; m += NGW) rwkv_gn_row(P, layer, (size_t)m, lane);
        }
        if (!(st >= 7 && st <= 11)) { if (gs == 0) grid.sync(); else xcd_barrier(xbar); }
#ifdef PROBE_A_LO
        if (blockIdx.x == 0 && threadIdx.x == 0) tsv[gs + 1] = __builtin_amdgcn_s_memrealtime();
#endif
    }
    { const int tid = tid_l(), lane = tid & 63; const int gw = blockIdx.x * 8 + (tid >> 6); const int NGW = gridDim.x * 8;
      for (int m = gw; m < MTOK; m += NGW) row_to_bf16(P.out + (size_t)m * DM, P.out + (size_t)m * DM, nullptr, P.ln_g + DM, P.ln_b + DM, true, lane); }
#ifdef PROBE_A_LO
    {
        float* dl = (float*)(P.ws + WS_CTL + 4096);
        if (blockIdx.x == 0 && threadIdx.x == 0) { const float ta = (float)(tsv[PROBE_A_HI] - tsv[PROBE_A_LO]) * 0.01f, tb = (float)(tsv[PROBE_B_HI] - tsv[PROBE_B_LO]) * 0.01f; dl[0] = ta; dl[1] = tb * 0.01f; }
        grid.sync();
        const float ta = __hip_atomic_load(dl, __ATOMIC_RELAXED, __HIP_MEMORY_SCOPE_AGENT), db = __hip_atomic_load(dl + 1, __ATOMIC_RELAXED, __HIP_MEMORY_SCOPE_AGENT);
        for (int i = blockIdx.x * NTHR + threadIdx.x; i < (1 << 20); i += gridDim.x * NTHR) P.out[i] += db + (i == 0 ? ta : 0.f);
    }
#endif
}

extern "C" void kernel_launch(void* const* d_in, const int* in_sizes, int n_in, void* d_out, int out_size, void* d_ws, size_t ws_size, hipStream_t stream) {
    static int grid = 0;
    if (grid == 0) {
        if (n_in != 20 || ws_size < WS_END) { fprintf(stderr, "kernel_launch: unexpected inputs (n_in %d, ws %zu)\n", n_in, ws_size); grid = -1; return; }
        int dev = 0, cus = 0, per_cu = 0;
        hipGetDevice(&dev); hipDeviceGetAttribute(&cus, hipDeviceAttributeMultiprocessorCount, dev);
        hipFuncSetAttribute((const void*)hybrid_fwd, hipFuncAttributeMaxDynamicSharedMemorySize, LDS_BYTES);
        hipOccupancyMaxActiveBlocksPerMultiprocessor(&per_cu, (const void*)hybrid_fwd, NTHR, LDS_BYTES);
        if (per_cu < 1) { fprintf(stderr, "kernel_launch: occupancy query says %d blocks per CU\n", per_cu); per_cu = 1; }
        grid = cus;
    }
    if (grid < 0) return;
    hipMemsetAsync((char*)d_ws + WS_CTL, 0, 1 * MiB, stream);
    Params p{};
    p.x = (const float*)d_in[0]; p.pos = (const int*)d_in[1]; p.w_in = (const float*)d_in[2]; p.mu = (const float*)d_in[3]; p.w0 = (const float*)d_in[4]; p.w_up = (const float*)d_in[5];
    p.a0 = (const float*)d_in[6]; p.a_up = (const float*)d_in[7]; p.k_k = (const float*)d_in[8]; p.k_a = (const float*)d_in[9]; p.r_k = (const float*)d_in[10]; p.gn_g = (const float*)d_in[11];
    p.gn_b = (const float*)d_in[12]; p.sinks = (const float*)d_in[13]; p.wba = (const float*)d_in[14]; p.wbb = (const float*)d_in[15]; p.wbc = (const float*)d_in[16]; p.w_out = (const float*)d_in[17];
    p.ln_g = (const float*)d_in[18]; p.ln_b = (const float*)d_in[19]; p.out = (float*)d_out; p.ws = (unsigned char*)d_ws;
    void* args[] = {&p};
    hipError_t e = hipLaunchCooperativeKernel((const void*)hybrid_fwd, dim3(grid), dim3(NTHR), args, LDS_BYTES, stream);
    if (e != hipSuccess) fprintf(stderr, "cooperative launch failed: %s (grid %d)\n", hipGetErrorString(e), grid);
}
```

```cpp
#include <hip/hip_runtime.h>
#include <hip/hip_cooperative_groups.h>
#include <cstdio>
#include <cstdint>
namespace cg = cooperative_groups;
__device__ __forceinline__ int tid_l() { int t = threadIdx.x; asm volatile("" : "+v"(t)); return t; }
namespace pg8 {
#define PG8_LAS __attribute__((address_space(3)))
typedef unsigned short bf16_t;
typedef short bf16x8 __attribute__((ext_vector_type(8)));
typedef float f32x4 __attribute__((ext_vector_type(4)));
typedef unsigned u32x4 __attribute__((ext_vector_type(4)));
constexpr int BM = 256, BK = 64, HALF = 128, HTB = HALF * BK * 2  , STAGE_BYTES = 8 * HTB, NXCD = 8, WGM = 8;

__host__ __device__ __forceinline__ int lds_byte(int r, int c) { const int st = (r >> 4) * 2 + (c >> 5), rr = r & 15, cc = c & 31, ob = rr * 64 + cc * 2; return st * 1024 + (ob ^ (((ob >> 9) & 1) << 5)); }
__host__ __device__ __forceinline__ void stage_rc(int b, int& R, int& C) { const int st = b / 1024, sb = b % 1024, swz = sb ^ (((sb >> 9) & 1) << 5); R = (st >> 1) * 16 + swz / 64; C = (st & 1) * 32 + (swz % 64) / 2; }
__host__ __device__ __forceinline__ int perm32(int rho) { const int n = rho >> 4, i = rho & 15; return 8 * (i >> 2) + 4 * n + (i & 3); }

struct Unit { int pm, pn; };
struct Gemm { const bf16_t* A; const bf16_t* Bt; int M, N, K; };

struct StaticOrder {
    int nM, nN, nwg, G, c;
    __host__ __device__ void init(int M, int N, int G_, int c_) { nM = M / BM; nN = N / BM; nwg = nM * nN; G = G_; c = c_; }
    __host__ __device__ bool next(int i, Unit& u) const {
        const long L = (long)i * G + c; if (L >= nwg) return false;
        int wgid = (int)L; { const int q = nwg / NXCD, r = nwg % NXCD, xcd = wgid % NXCD, off = wgid / NXCD; wgid = (xcd < r ? xcd * (q + 1) : r * (q + 1) + (xcd - r) * q) + off; }
        const int nig = WGM * nN, gid = wgid / nig, fm = gid * WGM, gsz = (nM - fm) < WGM ? (nM - fm) : WGM;
        u.pm = fm + ((wgid % nig) % gsz); u.pn = (wgid % nig) / gsz; return true;
    }
    __device__ __forceinline__ void a_ready(const Unit&) const {}
    __device__ __forceinline__ void done(const Unit&) const {}
};

__device__ __forceinline__ unsigned cvt_pk_bf16(float lo, float hi) { unsigned r; asm volatile("v_cvt_pk_bf16_f32 %0, %1, %2" : "=v"(r) : "v"(lo), "v"(hi)); return r; }
template <class Epi, class Sched, bool ALIGN_EPI = false, bool SP2 = false>
__device__ __forceinline__ void gemm_phase(PG8_LAS unsigned char* lds, const Gemm g, const Sched& S, const Epi& E) {
    const int tid = tid_l(), wid = __builtin_amdgcn_readfirstlane(tid >> 6), lane = tid & 63, wr = wid >> 2, wc = wid & 3, fr = lane & 15, fq = lane >> 4;
    const int K = g.K, nt = K / BK;
    unsigned voffA[2], voffB[2];
#pragma unroll
    for (int i = 0; i < 2; ++i) { int R, C; stage_rc(tid * 16 + i * 8192, R, C); const int Rb = Epi::PERM ? ((R & ~31) + perm32(R & 31)) : R;
        voffA[i] = (unsigned)(R * K + C) * 2u; voffB[i] = (unsigned)(Rb * K + C) * 2u; }
    const size_t kstep = (size_t)(BK * 2);
    const size_t hstep = (size_t)HALF * K * 2;
    const size_t tstep = 2 * hstep;
    const unsigned ldsw = (unsigned)wid * 1024u;
    const int aoff = lds_byte(wr * 64 + fr, fq * 8), boff = lds_byte(wc * 32 + fr, fq * 8);
#define PG8_SA(b, h) (((b) * 2 + (h)) * HTB)
#define PG8_SB(b, h) ((4 + (b) * 2 + (h)) * HTB)
#define PG8_STAGE(bufoff, gbase, voff) do { _Pragma("unroll") for (int _i = 0; _i < 2; ++_i) \
        __builtin_amdgcn_global_load_lds((const unsigned*)((const char*)(gbase) + (voff)[_i]), (PG8_LAS unsigned*)(lds + (bufoff) + ldsw + _i * 8192), 16, 0, 0); } while (0)
#define PG8_LDA(dst, b, h) do { _Pragma("unroll") for (int m = 0; m < 4; ++m) _Pragma("unroll") for (int k = 0; k < 2; ++k) dst[m][k] = *(const PG8_LAS bf16x8*)(lds + PG8_SA(b, h) + aoff + m * 2048 + k * 1024); } while (0)
#define PG8_LDB(dst, b, h) do { _Pragma("unroll") for (int n = 0; n < 2; ++n) _Pragma("unroll") for (int k = 0; k < 2; ++k) dst[n][k] = *(const PG8_LAS bf16x8*)(lds + PG8_SB(b, h) + boff + n * 2048 + k * 1024); } while (0)
#define PG8_MMA(ai, bj, At, Bt) do { __builtin_amdgcn_s_setprio(1); _Pragma("unroll") for (int m = 0; m < 4; ++m) _Pragma("unroll") for (int n = 0; n < 2; ++n) _Pragma("unroll") for (int k = 0; k < 2; ++k) \
        acc[ai][bj][m][n] = __builtin_amdgcn_mfma_f32_16x16x32_bf16(Bt[n][k], At[m][k], acc[ai][bj][m][n], 0, 0, 0); __builtin_amdgcn_s_setprio(0); } while (0)
#define PG8_WAIT_V(n) asm volatile("s_waitcnt vmcnt(" #n ")" ::: "memory")
#define PG8_WAIT_L(n) asm volatile("s_waitcnt lgkmcnt(" #n ")" ::: "memory")
#define PG8_BAR __builtin_amdgcn_s_barrier()
#define PG8_SCHED __builtin_amdgcn_sched_barrier(0)
    Unit cur, nxt; int ui = 0;
    if (!S.next(0, cur)) return;
    f32x4 acc[2][2][4][2];
#pragma unroll
    for (int a = 0; a < 2; ++a)
#pragma unroll
        for (int b = 0; b < 2; ++b)
#pragma unroll
            for (int m = 0; m < 4; ++m)
#pragma unroll
                for (int n = 0; n < 2; ++n) acc[a][b][m][n] = (f32x4){0.f, 0.f, 0.f, 0.f};
    bf16x8 At[4][2], B0[2][2], B1[2][2];
    const char* cA = (const char*)g.A + (size_t)cur.pm * tstep; const char* cB = (const char*)g.Bt + (size_t)cur.pn * tstep;
    S.a_ready(cur);
    if constexpr (SP2) {
        PG8_STAGE(PG8_SB(0, 0), cB, voffB); PG8_STAGE(PG8_SB(0, 1), cB + hstep, voffB); PG8_STAGE(PG8_SA(0, 0), cA, voffA); PG8_STAGE(PG8_SA(0, 1), cA + hstep, voffA);
        if (wr == 1) PG8_BAR;
        PG8_WAIT_V(2); PG8_BAR;
        PG8_STAGE(PG8_SB(1, 0), cB + kstep, voffB); PG8_STAGE(PG8_SA(1, 0), cA + kstep, voffA); PG8_STAGE(PG8_SB(1, 1), cB + hstep + kstep, voffB);
        PG8_WAIT_V(6); PG8_BAR;
    } else {
        PG8_STAGE(PG8_SB(0, 0), cB, voffB); PG8_STAGE(PG8_SA(0, 0), cA, voffA); PG8_STAGE(PG8_SB(0, 1), cB + hstep, voffB); PG8_STAGE(PG8_SA(0, 1), cA + hstep, voffA);
        if (wr == 1) PG8_BAR;
        PG8_WAIT_V(4); PG8_BAR;
        PG8_STAGE(PG8_SB(1, 0), cB + kstep, voffB); PG8_STAGE(PG8_SA(1, 0), cA + kstep, voffA); PG8_STAGE(PG8_SB(1, 1), cB + hstep + kstep, voffB);
        PG8_WAIT_V(6); PG8_BAR;
    }
    for (;;) {
        const bool has_next = S.next(ui + 1, nxt);
        const char* nA = has_next ? (const char*)g.A + (size_t)nxt.pm * tstep : cA; const char* nB = has_next ? (const char*)g.Bt + (size_t)nxt.pn * tstep : cB;
        for (int t = 0; t < nt; t += 2) {
            const bool last = (t == nt - 2);
            const char* a1 = cA + (size_t)(t + 1) * kstep;
            const char* a2 = last ? nA : cA + (size_t)(t + 2) * kstep; const char* b2 = last ? nB : cB + (size_t)(t + 2) * kstep;
            const char* a3 = a2 + kstep; const char* b3 = b2 + kstep;
            if (last && has_next) S.a_ready(nxt);
            if constexpr (SP2) {
            PG8_LDB(B0, 0, 0); PG8_LDB(B1, 0, 1); PG8_SCHED; PG8_LDA(At, 0, 0); PG8_STAGE(PG8_SA(1, 1), a1 + hstep, voffA);
            PG8_WAIT_V(8); PG8_WAIT_L(0); PG8_BAR; PG8_MMA(0, 0, At, B0); PG8_MMA(0, 1, At, B1); PG8_BAR; PG8_SCHED;
            PG8_LDA(At, 0, 1); PG8_STAGE(PG8_SB(0, 0), b2, voffB); PG8_STAGE(PG8_SB(0, 1), b2 + hstep, voffB); PG8_STAGE(PG8_SA(0, 0), a2, voffA);
            PG8_WAIT_V(8); PG8_WAIT_L(0); PG8_BAR; PG8_MMA(1, 0, At, B0); PG8_MMA(1, 1, At, B1); PG8_BAR; PG8_SCHED;
            PG8_LDB(B0, 1, 0); PG8_LDB(B1, 1, 1); PG8_SCHED; PG8_LDA(At, 1, 0); PG8_STAGE(PG8_SA(0, 1), a2 + hstep, voffA);
            PG8_WAIT_V(8); PG8_WAIT_L(0); PG8_BAR; PG8_MMA(0, 0, At, B0); PG8_MMA(0, 1, At, B1); PG8_BAR; PG8_SCHED;
            PG8_LDA(At, 1, 1); PG8_STAGE(PG8_SB(1, 0), b3, voffB); PG8_STAGE(PG8_SB(1, 1), b3 + hstep, voffB); PG8_STAGE(PG8_SA(1, 0), a3, voffA);
            PG8_WAIT_V(8); PG8_WAIT_L(0); PG8_BAR; PG8_MMA(1, 0, At, B0); PG8_MMA(1, 1, At, B1); PG8_BAR; PG8_SCHED;
            } else {
            PG8_LDB(B0, 0, 0); PG8_SCHED; PG8_LDA(At, 0, 0); PG8_STAGE(PG8_SA(1, 1), a1 + hstep, voffA);
            PG8_WAIT_L(8); PG8_BAR; PG8_WAIT_L(0); PG8_MMA(0, 0, At, B0); PG8_BAR; PG8_SCHED;
            PG8_LDB(B1, 0, 1); PG8_STAGE(PG8_SB(0, 0), b2, voffB);
            PG8_BAR; PG8_WAIT_L(0); PG8_MMA(0, 1, At, B1); PG8_BAR;
            PG8_LDA(At, 0, 1); PG8_STAGE(PG8_SA(0, 0), a2, voffA);
            PG8_BAR; PG8_WAIT_L(0); PG8_MMA(1, 0, At, B0); PG8_BAR; PG8_SCHED;
            PG8_STAGE(PG8_SB(0, 1), b2 + hstep, voffB);
            PG8_WAIT_V(6); PG8_BAR; PG8_MMA(1, 1, At, B1); PG8_BAR;
            PG8_LDB(B0, 1, 0); PG8_SCHED; PG8_LDA(At, 1, 0); PG8_STAGE(PG8_SA(0, 1), a2 + hstep, voffA);
            PG8_WAIT_L(8); PG8_BAR; PG8_WAIT_L(0); PG8_MMA(0, 0, At, B0); PG8_BAR; PG8_SCHED;
            PG8_LDB(B1, 1, 1); PG8_STAGE(PG8_SB(1, 0), b3, voffB);
            PG8_BAR; PG8_WAIT_L(0); PG8_MMA(0, 1, At, B1); PG8_BAR;
            PG8_LDA(At, 1, 1); PG8_STAGE(PG8_SA(1, 0), a3, voffA);
            PG8_BAR; PG8_WAIT_L(0); PG8_MMA(1, 0, At, B0); PG8_BAR; PG8_SCHED;
            PG8_STAGE(PG8_SB(1, 1), b3 + hstep, voffB);
            PG8_WAIT_V(6); PG8_BAR; PG8_MMA(1, 1, At, B1); PG8_BAR;
            }
        }
        if constexpr (ALIGN_EPI) { if (wr == 0) PG8_BAR; }
        if constexpr (!Epi::AFTER_DRAIN) { E(acc, cur, wr, wc, fr, fq); S.done(cur); }
        if (!has_next) break;
#pragma unroll
        for (int a = 0; a < 2; ++a)
#pragma unroll
            for (int b = 0; b < 2; ++b)
#pragma unroll
                for (int m = 0; m < 4; ++m)
#pragma unroll
                    for (int n = 0; n < 2; ++n) acc[a][b][m][n] = (f32x4){0.f, 0.f, 0.f, 0.f};
        cur = nxt; cA = nA; cB = nB; ++ui;
        if constexpr (ALIGN_EPI) { if (wr == 1) PG8_BAR; }
    }
    PG8_WAIT_V(0);
    if constexpr (!ALIGN_EPI) { if (wr == 0) PG8_BAR; }
    PG8_BAR;
    if constexpr (Epi::AFTER_DRAIN) { E.fused(acc, cur, wr, wc, fr, fq, lds, wid, lane); S.done(cur); }
#undef PG8_SA
#undef PG8_SB
#undef PG8_STAGE
#undef PG8_LDA
#undef PG8_LDB
#undef PG8_MMA
#undef PG8_WAIT_V
#undef PG8_WAIT_L
#undef PG8_BAR
#undef PG8_SCHED
}
}

#define LAS __attribute__((address_space(3)))
using pg8::bf16_t; using pg8::bf16x8; using pg8::f32x4; using pg8::Unit;
typedef float f32x16 __attribute__((ext_vector_type(16)));
typedef unsigned u32x4 __attribute__((ext_vector_type(4)));
typedef unsigned u32x2 __attribute__((ext_vector_type(2)));

constexpr int MTOK = 16384, SEQL = 8192, DM = 1024, INW = 8576, NLAYER = 2;
constexpr float C2F = 0.125f * 1.4426950408889634f;
constexpr float LOG2E = 1.4426950408889634f;
constexpr float NEGF = -1.0e30f;
constexpr float ALPHA_RES = 1.4142135623730951f;
constexpr int NTHR = 512;
#ifndef PHMASK
#define PHMASK 0x1ff
#endif
constexpr int LDS_BYTES = 147456;

constexpr size_t MiB = 1u << 20;
constexpr size_t WS_CTL = 0;
constexpr size_t WS_COS = 1 * MiB;
constexpr size_t WS_SIN = 3 * MiB;
constexpr size_t WS_KMEAN = 5 * MiB;
constexpr size_t WS_RK = 5 * MiB + 256 * 1024;
constexpr size_t WS_BND = 6 * MiB;
constexpr size_t WS_XB = 7 * MiB;
constexpr size_t WS_WIN = 39 * MiB;
constexpr size_t WS_WBR = 56 * MiB;
constexpr size_t WS_WOUT = 59 * MiB;
constexpr size_t WS_QA = 61 * MiB;
constexpr size_t WS_KA = 77 * MiB;
constexpr size_t WS_VA = 93 * MiB;
constexpr size_t WS_RB = 109 * MiB;
constexpr size_t WS_KB = 125 * MiB;
constexpr size_t WS_VB = 141 * MiB;
constexpr size_t WS_MISC = 157 * MiB;
constexpr size_t WS_OB = 173 * MiB;
constexpr size_t WS_QC = 189 * MiB;
constexpr size_t WS_DW = 205 * MiB;
constexpr size_t WS_KK = 221 * MiB;
constexpr size_t WS_BB = 237 * MiB;
constexpr size_t WS_END = 253 * MiB;
constexpr size_t WS_Y = WS_KA;
constexpr size_t WS_MERGED = WS_RB;

__device__ __forceinline__ float bflo(unsigned u) { return __uint_as_float(u << 16); }
__device__ __forceinline__ float bfhi(unsigned u) { return __uint_as_float(u & 0xffff0000u); }
__device__ __forceinline__ unsigned pk2(float lo, float hi) { return pg8::cvt_pk_bf16(lo, hi); }
__device__ __forceinline__ float sigmoidf_(float x) { return __builtin_amdgcn_rcpf(1.0f + __expf(-x)); }
__device__ __forceinline__ int crow(int r, int hi) { return (r & 3) + 8 * (r >> 2) + 4 * hi; }
#define LDS_WAIT() asm volatile("s_waitcnt lgkmcnt(0)" ::: "memory")

struct Params;
__device__ __forceinline__ unsigned char* wsl(const Params& P);
struct Params {
    const float* x; const int* pos; const float* w_in; const float* mu; const float* w0; const float* w_up; const float* a0; const float* a_up;
    const float* k_k; const float* k_a; const float* r_k; const float* gn_g; const float* gn_b; const float* sinks;
    const float* wba; const float* wbb; const float* wbc; const float* w_out; const float* ln_g; const float* ln_b;
    float* out; unsigned char* ws;
};

typedef __attribute__((address_space(1))) unsigned char gas_uchar;
__device__ __forceinline__ unsigned char* wsl(const Params& P) { gas_uchar* w = (gas_uchar*)P.ws; asm volatile("" : "+s"(w)); return (unsigned char*)w; }

struct Epi1 {
    static constexpr bool PERM = false, AFTER_DRAIN = false;
    unsigned char* ws;
    __device__ __forceinline__ void operator()(const f32x4 (&acc)[2][2][4][2], const Unit& u, int wr, int wc, int fr, int fq) const {
        const int pn = u.pn; const int row0 = u.pm * 256 + wr * 64 + fr;
        const float* cosT = (const float*)(ws + WS_COS); const float* sinT = (const float*)(ws + WS_SIN); float* KMEAN = (float*)(ws + WS_KMEAN); bf16_t* BND = (bf16_t*)(ws + WS_BND);
#pragma unroll
        for (int bj = 0; bj < 2; ++bj) {
            int kind = 0; size_t doff = 0; constexpr int pitch = 512; int cb = 0; float sc = 1.f; int bcol = -1; const int tcol = 128 * bj;
            if (pn < 12) { doff = WS_QA + (size_t)(pn >> 1) * (16 * MiB); cb = (pn & 1) * 256 + tcol; kind = pn < 4 ? 1 : 0; if (pn < 2) sc = C2F; if (pn >= 6) bcol = ((pn - 6) >> 1) * 512 + cb; }
            else if (pn == 12) { if (bj == 0) { doff = WS_MISC; cb = 256; bcol = 1536; } else kind = 2; }
            else if (pn < 15) { kind = 1; doff = WS_QC; cb = (pn - 13) * 256 + tcol; sc = C2F; }
            else { doff = WS_MISC; if (bj == 0) { kind = 1; cb = 0; } else { cb = 128; } }
            bf16_t* dst = (bf16_t*)(ws + doff);
            if (kind == 2) continue;
            if (kind == 0) {
#pragma unroll
                for (int ai = 0; ai < 2; ++ai)
#pragma unroll
                    for (int m = 0; m < 4; ++m) { const int row = row0 + ai * 128 + m * 16;
#pragma unroll
                        for (int n = 0; n < 2; ++n) { const f32x4 v = acc[ai][bj][m][n]; u32x2 w; w.x = pk2(v[0], v[1]); w.y = pk2(v[2], v[3]);
                            const int c = 32 * wc + 16 * n + 4 * fq;
                            *(u32x2*)(dst + (unsigned)(row * pitch + cb + c)) = w;
                            if (bcol >= 0 && m == 3 && fr == 15) *(u32x2*)(BND + (unsigned)((row >> 6) * 1664 + bcol + c)) = w; }
                        asm volatile("" ::: "memory"); }
            } else {
                const int f0 = 16 * (wc & 1) + 4 * fq; const int c1 = cb + 64 * (wc >> 1) + f0;
                const bool km = (pn == 2 || pn == 3);
                f32x4 s1 = {0.f, 0.f, 0.f, 0.f}, s2 = {0.f, 0.f, 0.f, 0.f};
#pragma unroll
                for (int ai = 0; ai < 2; ++ai) {
                    f32x4 cs[4], sn[4];
#pragma unroll
                    for (int m = 0; m < 4; ++m) { const int row = row0 + ai * 128 + m * 16; cs[m] = *(const f32x4*)(cosT + (unsigned)(row * 32 + f0)); sn[m] = *(const f32x4*)(sinT + (unsigned)(row * 32 + f0)); }
#pragma unroll
                    for (int m = 0; m < 4; ++m) { const int row = row0 + ai * 128 + m * 16;
                        const f32x4 x1 = acc[ai][bj][m][0], x2 = acc[ai][bj][m][1];
                        const f32x4 o1 = x1 * cs[m] - x2 * sn[m], o2 = x2 * cs[m] + x1 * sn[m];
                        s1 += o1; s2 += o2;
                        u32x2 w; w.x = pk2(o1[0] * sc, o1[1] * sc); w.y = pk2(o1[2] * sc, o1[3] * sc);
                        *(u32x2*)(dst + (unsigned)(row * pitch + c1)) = w;
                        w.x = pk2(o2[0] * sc, o2[1] * sc); w.y = pk2(o2[2] * sc, o2[3] * sc);
                        *(u32x2*)(dst + (unsigned)(row * pitch + c1 + 32)) = w; }
                    asm volatile("" ::: "memory");
                }
                if (km) {
#pragma unroll
                    for (int j = 0; j < 4; ++j) {
                        float a = s1[j], b = s2[j];
#pragma unroll
                        for (int o = 1; o < 16; o <<= 1) { a += __shfl_xor(a, o); b += __shfl_xor(b, o); }
                        if (fr == 0) { atomicAdd(KMEAN + (unsigned)(u.pm * 512 + c1 + j), a); atomicAdd(KMEAN + (unsigned)(u.pm * 512 + c1 + 32 + j), b); }
                    }
                }
            }
        }
    }
};

struct EpiZ {
    static constexpr bool PERM = false, AFTER_DRAIN = false;
    unsigned char* ws;
    __device__ __forceinline__ void operator()(const f32x4 (&acc)[2][2][4][2], const Unit& u, int wr, int wc, int fr, int fq) const {
        const int br = u.pn >> 1; bf16_t* O = (bf16_t*)(ws + (br == 0 ? WS_QA : (br == 1 ? WS_DW : WS_QC)));
        const int row0 = u.pm * 256 + wr * 64 + fr; const int cb = (u.pn & 1) * 256 + 32 * wc + 4 * fq;
#pragma unroll
        for (int ai = 0; ai < 2; ++ai)
#pragma unroll
            for (int mh = 0; mh < 2; ++mh) {
                u32x2 o[2][2][2];
                if (br != 1) {
#pragma unroll
                    for (int mm = 0; mm < 2; ++mm) { const int row = row0 + ai * 128 + (mh * 2 + mm) * 16;
#pragma unroll
                        for (int bj = 0; bj < 2; ++bj)
#pragma unroll
                            for (int n = 0; n < 2; ++n) o[mm][bj][n] = *(const u32x2*)(O + (unsigned)(row * 512 + cb + 128 * bj + 16 * n)); }
                }
#pragma unroll
                for (int mm = 0; mm < 2; ++mm) { const int m = mh * 2 + mm; const int row = row0 + ai * 128 + m * 16;
#pragma unroll
                    for (int bj = 0; bj < 2; ++bj)
#pragma unroll
                        for (int n = 0; n < 2; ++n) { const f32x4 z = acc[ai][bj][m][n]; u32x2 w;
                            if (br == 1) { w.x = pk2(z[0], z[1]); w.y = pk2(z[2], z[3]); }
                            else { const u32x2 ov = o[mm][bj][n];
                                w.x = pk2(bflo(ov.x) * z[0] * sigmoidf_(z[0]), bfhi(ov.x) * z[1] * sigmoidf_(z[1]));
                                w.y = pk2(bflo(ov.y) * z[2] * sigmoidf_(z[2]), bfhi(ov.y) * z[3] * sigmoidf_(z[3])); }
                            *(u32x2*)(O + (unsigned)(row * 512 + cb + 128 * bj + 16 * n)) = w; } }
                asm volatile("" ::: "memory");
            }
    }
};

struct EpiY {
    static constexpr bool PERM = false, AFTER_DRAIN = false;
    bf16_t* Y;
    __device__ __forceinline__ void operator()(const f32x4 (&acc)[2][2][4][2], const Unit& u, int wr, int wc, int fr, int fq) const {
        const int row0 = u.pm * 256 + wr * 64 + fr; const int cb = u.pn * 256 + 32 * wc + 4 * fq;
#pragma unroll
        for (int ai = 0; ai < 2; ++ai)
#pragma unroll
            for (int m = 0; m < 4; ++m) { const int row = row0 + ai * 128 + m * 16;
#pragma unroll
                for (int bj = 0; bj < 2; ++bj)
#pragma unroll
                    for (int n = 0; n < 2; ++n) { const f32x4 v = acc[ai][bj][m][n]; u32x2 w; w.x = pk2(v[0], v[1]); w.y = pk2(v[2], v[3]);
                        *(u32x2*)(Y + (unsigned)(row * 1024 + cb + 128 * bj + 16 * n)) = w; } }
    }
};

struct EpiG {
    static constexpr bool PERM = false, AFTER_DRAIN = false;
    const bf16_t* Y; bf16_t* MG; int first;
    __device__ __forceinline__ void operator()(const f32x4 (&acc)[2][2][4][2], const Unit& u, int wr, int wc, int fr, int fq) const {
        const int row0 = u.pm * 256 + wr * 64 + fr; const int cb = u.pn * 256 + 32 * wc + 4 * fq;
#pragma unroll
        for (int ai = 0; ai < 2; ++ai)
#pragma unroll
            for (int mh = 0; mh < 2; ++mh) {
                u32x2 yv[2][2][2], mv[2][2][2];
#pragma unroll
                for (int mm = 0; mm < 2; ++mm) { const int row = row0 + ai * 128 + (mh * 2 + mm) * 16;
#pragma unroll
                    for (int bj = 0; bj < 2; ++bj)
#pragma unroll
                        for (int n = 0; n < 2; ++n) { const unsigned off = (unsigned)(row * 1024 + cb + 128 * bj + 16 * n);
                            yv[mm][bj][n] = *(const u32x2*)(Y + off); mv[mm][bj][n] = (u32x2){0u, 0u}; if (!first) mv[mm][bj][n] = *(const u32x2*)(MG + off); } }
#pragma unroll
                for (int mm = 0; mm < 2; ++mm) { const int m = mh * 2 + mm; const int row = row0 + ai * 128 + m * 16;
#pragma unroll
                    for (int bj = 0; bj < 2; ++bj)
#pragma unroll
                        for (int n = 0; n < 2; ++n) { const f32x4 g = acc[ai][bj][m][n]; const unsigned off = (unsigned)(row * 1024 + cb + 128 * bj + 16 * n);
                            const u32x2 y = yv[mm][bj][n], mg = mv[mm][bj][n]; u32x2 w;
                            w.x = pk2(bflo(mg.x) + sigmoidf_(g[0]) * bflo(y.x), bfhi(mg.x) + sigmoidf_(g[1]) * bfhi(y.x));
                            w.y = pk2(bflo(mg.y) + sigmoidf_(g[2]) * bflo(y.y), bfhi(mg.y) + sigmoidf_(g[3]) * bfhi(y.y));
                            *(u32x2*)(MG + off) = w; } }
                asm volatile("" ::: "memory");
            }
    }
};

struct EpiOut {
    static constexpr bool PERM = false, AFTER_DRAIN = false;
    const float* xres; float* out;
    __device__ __forceinline__ void operator()(const f32x4 (&acc)[2][2][4][2], const Unit& u, int wr, int wc, int fr, int fq) const {
        const int row0 = u.pm * 256 + wr * 64 + fr; const int cb = u.pn * 256 + 32 * wc + 4 * fq;
#pragma unroll
        for (int ai = 0; ai < 2; ++ai)
#pragma unroll
            for (int mh = 0; mh < 2; ++mh) {
                f32x4 xr[2][2][2];
#pragma unroll
                for (int mm = 0; mm < 2; ++mm) { const int row = row0 + ai * 128 + (mh * 2 + mm) * 16;
#pragma unroll
                    for (int bj = 0; bj < 2; ++bj)
#pragma unroll
                        for (int n = 0; n < 2; ++n) xr[mm][bj][n] = *(const f32x4*)(xres + (unsigned)(row * 1024 + cb + 128 * bj + 16 * n)); }
#pragma unroll
                for (int mm = 0; mm < 2; ++mm) { const int m = mh * 2 + mm; const int row = row0 + ai * 128 + m * 16;
#pragma unroll
                    for (int bj = 0; bj < 2; ++bj)
#pragma unroll
                        for (int n = 0; n < 2; ++n) *(f32x4*)(out + (unsigned)(row * 1024 + cb + 128 * bj + 16 * n)) = xr[mm][bj][n] * ALPHA_RES + acc[ai][bj][m][n]; }
                asm volatile("" ::: "memory");
            }
    }
};

struct EpiAll {
    static constexpr bool PERM = false, AFTER_DRAIN = false;
    Epi1 e1; EpiZ ez; EpiY ey; EpiG eg; EpiOut eo; int mode;
    __device__ __forceinline__ void operator()(const f32x4 (&acc)[2][2][4][2], const Unit& u, int wr, int wc, int fr, int fq) const {
        if (mode == 0) e1(acc, u, wr, wc, fr, fq);
        else if (mode == 1) ez(acc, u, wr, wc, fr, fq);
        else if (mode == 2) ey(acc, u, wr, wc, fr, fq);
        else if (mode == 3) eg(acc, u, wr, wc, fr, fq);
        else if (mode == 4) eo(acc, u, wr, wc, fr, fq);
    }
};

__device__ __forceinline__ int rope_perm(int q) { const int hd = q >> 6, r = q & 63; return hd * 64 + 16 * (r >> 5) + (r & 15) + 32 * ((r >> 4) & 1); }
__device__ __forceinline__ int win_map(int p) {
    if (p < 4096) {
        const int t = p >> 8, q = p & 255;
        if (t < 2) return t * 256 + rope_perm(q);
        if (t < 4) return 512 + (t - 2) * 256 + rope_perm(q);
        if (t < 6) return 1024 + (t - 4) * 256 + q;
        if (t < 8) return 2048 + (t - 6) * 256 + q;
        if (t < 10) return 2560 + (t - 8) * 256 + q;
        if (t < 12) return 3072 + (t - 10) * 256 + q;
        if (t == 12) return q < 128 ? 3584 + q : -1;
        if (t < 15) return 4224 + (t - 13) * 256 + rope_perm(q);
        return q < 128 ? 4736 + rope_perm(q) : 4864 + (q - 128);
    }
    if (p < 5632) { const int q = p - 4096, br = q >> 9, c = q & 511; return br == 0 ? 1536 + c : (br == 1 ? 3712 + c : 4992 + c); }
    return 5504 + (p - 5632);
}
__device__ __forceinline__ void transpose_item(const float* W, int Nsrc, bf16_t* WT, int K, int k0, int p0, int srccol, LAS float* scr, int lane) {
#pragma unroll
    for (int i = 0; i < 8; ++i) { const int kk = 8 * i + (lane >> 3);
        f32x4 v = {0.f, 0.f, 0.f, 0.f}; if (srccol >= 0) v = *(const f32x4*)(W + (size_t)(k0 + kk) * Nsrc + srccol);
        LAS float* d = scr + kk * 33 + 4 * (lane & 7); d[0] = v[0]; d[1] = v[1]; d[2] = v[2]; d[3] = v[3]; }
    LDS_WAIT();
    const int c = lane & 7;
#pragma unroll
    for (int j = 0; j < 4; ++j) { const int n = (lane >> 3) + 8 * j; const LAS float* s = scr + (8 * c) * 33 + n;
        u32x4 o; o.x = pk2(s[0 * 33], s[1 * 33]); o.y = pk2(s[2 * 33], s[3 * 33]); o.z = pk2(s[4 * 33], s[5 * 33]); o.w = pk2(s[6 * 33], s[7 * 33]);
        *(u32x4*)(WT + (size_t)(p0 + n) * K + k0 + 8 * c) = o; }
    LDS_WAIT();
}
__device__ __forceinline__ float wave_sum(float v) {
#pragma unroll
    for (int o = 1; o < 64; o <<= 1) v += __shfl_xor(v, o);
    return v;
}
__device__ __forceinline__ void row_to_bf16(const float* src, float* dst_f32, bf16_t* dst_bf, const float* g, const float* b, bool do_ln, int lane) {
    const f32x4* xr = (const f32x4*)src + lane;
    f32x4 v[4]; float s = 0.f;
#pragma unroll
    for (int j = 0; j < 4; ++j) { v[j] = xr[64 * j]; s += (v[j][0] + v[j][1]) + (v[j][2] + v[j][3]); }
    if (do_ln) {
        const float mean = wave_sum(s) * (1.f / 1024.f); float s2 = 0.f;
#pragma unroll
        for (int j = 0; j < 4; ++j) { v[j] = v[j] - mean; s2 += (v[j][0] * v[j][0] + v[j][1] * v[j][1]) + (v[j][2] * v[j][2] + v[j][3] * v[j][3]); }
        const float rstd = 1.0f / sqrtf(wave_sum(s2) * (1.f / 1024.f) + 1e-5f);
#pragma unroll
        for (int j = 0; j < 4; ++j) { const f32x4 gg = ((const f32x4*)g)[lane + 64 * j], bb = ((const f32x4*)b)[lane + 64 * j]; v[j] = v[j] * rstd * gg + bb; }
        if (dst_f32) {
#pragma unroll
            for (int j = 0; j < 4; ++j) ((f32x4*)dst_f32)[lane + 64 * j] = v[j];
        }
    }
    if (dst_bf) {
#pragma unroll
        for (int j = 0; j < 4; ++j) { u32x2 w; w.x = pk2(v[j][0], v[j][1]); w.y = pk2(v[j][2], v[j][3]); ((u32x2*)dst_bf)[lane + 64 * j] = w; }
    }
}

constexpr int KS_PITCH = 144, VT_PITCH = 80, VT_TILE = 64 * 80;
constexpr int ALDS_K = 0, ALDS_V = 55296, ALDS_KM = 116736, ALDS_SEL = 124672;

template <int MASK, class MaskF>
__device__ __forceinline__ void attn_tile(const LAS unsigned char* Kt, const LAS unsigned char* Vt, const bf16x8 (&qf)[4], float& m, float& l, f32x16& o0, f32x16& o1,
                                          int r32, int hi, bool lane_on, MaskF valid) {
    f32x16 s;
#pragma unroll
    for (int r = 0; r < 16; ++r) s[r] = 0.f;
#pragma unroll
    for (int ks = 0; ks < 4; ++ks) { const bf16x8 a = *(const LAS bf16x8*)(Kt + r32 * KS_PITCH + (ks * 16 + hi * 8) * 2); s = __builtin_amdgcn_mfma_f32_32x32x16_bf16(a, qf[ks], s, 0, 0, 0); }
    if (MASK == 1) {
#pragma unroll
        for (int r = 0; r < 16; ++r) if (!valid(crow(r, hi))) s[r] = NEGF;
    }
    float mx = s[0];
#pragma unroll
    for (int r = 1; r < 16; ++r) mx = fmaxf(mx, s[r]);
    if (MASK == 2) mx = lane_on ? mx : NEGF;
    { const auto rr_ = __builtin_amdgcn_permlane32_swap(__float_as_uint(mx), __float_as_uint(mx), false, false); mx = fmaxf(__uint_as_float(rr_[0]), __uint_as_float(rr_[1])); }
    const float mn = fmaxf(m, mx);
    if (__any(mn > m)) {
        const float alpha = __builtin_amdgcn_exp2f(m - mn); m = mn; l *= alpha;
#pragma unroll
        for (int r = 0; r < 16; ++r) { o0[r] *= alpha; o1[r] *= alpha; }
    }
    float ps = 0.f;
#pragma unroll
    for (int r = 0; r < 16; ++r) { s[r] = __builtin_amdgcn_exp2f(s[r] - mn); ps += s[r]; }
    if (MASK == 2) ps = lane_on ? ps : 0.f;
    l += ps;
#pragma unroll
    for (int s2 = 0; s2 < 2; ++s2) {
        u32x4 pw; pw.x = pk2(s[8 * s2 + 0], s[8 * s2 + 1]); pw.y = pk2(s[8 * s2 + 2], s[8 * s2 + 3]); pw.z = pk2(s[8 * s2 + 4], s[8 * s2 + 5]); pw.w = pk2(s[8 * s2 + 6], s[8 * s2 + 7]);
        if (MASK == 2) { pw.x = lane_on ? pw.x : 0u; pw.y = lane_on ? pw.y : 0u; pw.z = lane_on ? pw.z : 0u; pw.w = lane_on ? pw.w : 0u; }
        const bf16x8 pb = __builtin_bit_cast(bf16x8, pw);
        { const LAS unsigned char* vp = Vt + r32 * VT_PITCH + (16 * s2 + 4 * hi) * 2; const u32x2 lo = *(const LAS u32x2*)vp, hh = *(const LAS u32x2*)(vp + 16);
          u32x4 aw; aw.x = lo.x; aw.y = lo.y; aw.z = hh.x; aw.w = hh.y; o0 = __builtin_amdgcn_mfma_f32_32x32x16_bf16(__builtin_bit_cast(bf16x8, aw), pb, o0, 0, 0, 0); }
        { const LAS unsigned char* vp = Vt + (32 + r32) * VT_PITCH + (16 * s2 + 4 * hi) * 2; const u32x2 lo = *(const LAS u32x2*)vp, hh = *(const LAS u32x2*)(vp + 16);
          u32x4 aw; aw.x = lo.x; aw.y = lo.y; aw.z = hh.x; aw.w = hh.y; o1 = __builtin_amdgcn_mfma_f32_32x32x16_bf16(__builtin_bit_cast(bf16x8, aw), pb, o1, 0, 0, 0); }
    }
}
struct KvRegs { u32x4 k[4], v[4]; };
__device__ __forceinline__ void kv_load256(KvRegs& R, const bf16_t* Ksrc, const bf16_t* Vsrc, int pitch, int tid) {
#pragma unroll
    for (int i = 0; i < 4; ++i) { const int q = tid + NTHR * i; const int key = q >> 3, pc = q & 7; R.k[i] = *(const u32x4*)(Ksrc + (size_t)key * pitch + pc * 8); }
#pragma unroll
    for (int i = 0; i < 4; ++i) { const int q = tid + NTHR * i; const int key = q & 255, pc = q >> 8; R.v[i] = *(const u32x4*)(Vsrc + (size_t)key * pitch + pc * 8); }
}
__device__ __forceinline__ void kv_store256(LAS unsigned char* lds, const KvRegs& R, int tid) {
#pragma unroll
    for (int i = 0; i < 4; ++i) { const int q = tid + NTHR * i; const int key = q >> 3, pc = q & 7; *(LAS u32x4*)(lds + ALDS_K + key * KS_PITCH + pc * 16) = R.k[i]; }
#pragma unroll
    for (int i = 0; i < 4; ++i) { const int q = tid + NTHR * i; const int key = q & 255, pc = q >> 8; const u32x4 vv = R.v[i];
        LAS unsigned short* vt = (LAS unsigned short*)(lds + ALDS_V + (key >> 5) * VT_TILE + (pc * 8) * VT_PITCH + (key & 31) * 2);
        vt[0 * 40] = (unsigned short)(vv.x & 0xffffu); vt[1 * 40] = (unsigned short)(vv.x >> 16);
        vt[2 * 40] = (unsigned short)(vv.y & 0xffffu); vt[3 * 40] = (unsigned short)(vv.y >> 16);
        vt[4 * 40] = (unsigned short)(vv.z & 0xffffu); vt[5 * 40] = (unsigned short)(vv.z >> 16);
        vt[6 * 40] = (unsigned short)(vv.w & 0xffffu); vt[7 * 40] = (unsigned short)(vv.w >> 16); }
}
__device__ __forceinline__ void stage_kv(LAS unsigned char* lds, const bf16_t* Ksrc, const bf16_t* Vsrc, int pitch, int nkeys, int first_valid, int tid) {
    for (int i = tid; i < nkeys * 8; i += NTHR) {
        const int key = i >> 3, pc = i & 7;
        if (key < first_valid) continue;
        const u32x4 kv = *(const u32x4*)(Ksrc + (size_t)key * pitch + pc * 8);
        *(LAS u32x4*)(lds + ALDS_K + key * KS_PITCH + pc * 16) = kv;
    }
    for (int i = tid; i < nkeys * 8; i += NTHR) {
        const int key = i % nkeys, pc = i / nkeys;
        if (key < first_valid) continue;
        const u32x4 vv = *(const u32x4*)(Vsrc + (size_t)key * pitch + pc * 8);
        LAS unsigned short* vt = (LAS unsigned short*)(lds + ALDS_V + (key >> 5) * VT_TILE + (pc * 8) * VT_PITCH + (key & 31) * 2);
        vt[0 * 40] = (unsigned short)(vv.x & 0xffffu); vt[1 * 40] = (unsigned short)(vv.x >> 16);
        vt[2 * 40] = (unsigned short)(vv.y & 0xffffu); vt[3 * 40] = (unsigned short)(vv.y >> 16);
        vt[4 * 40] = (unsigned short)(vv.z & 0xffffu); vt[5 * 40] = (unsigned short)(vv.z >> 16);
        vt[6 * 40] = (unsigned short)(vv.w & 0xffffu); vt[7 * 40] = (unsigned short)(vv.w >> 16);
    }
}
__device__ __forceinline__ void attn_store(bf16_t* O, int pitch, const f32x16& o0, const f32x16& o1, float inv, int hi) {
#pragma unroll
    for (int g = 0; g < 4; ++g) {
        u32x2 w; w.x = pk2(o0[4 * g] * inv, o0[4 * g + 1] * inv); w.y = pk2(o0[4 * g + 2] * inv, o0[4 * g + 3] * inv);
        *(u32x2*)(O + 8 * g + 4 * hi) = w;
        w.x = pk2(o1[4 * g] * inv, o1[4 * g + 1] * inv); w.y = pk2(o1[4 * g + 2] * inv, o1[4 * g + 3] * inv);
        *(u32x2*)(O + 32 + 8 * g + 4 * hi) = w;
    }
}

__device__ __forceinline__ void moba_item(unsigned char* ldsg, LAS unsigned char* lds, const Params& P, int b, int h, int n, bool dry = false) {
    const int tid = tid_l(), lane = tid & 63, r32 = lane & 31, hi = lane >> 5; const int w = __builtin_amdgcn_readfirstlane(tid >> 6);
    bf16_t* QA = (bf16_t*)(wsl(P) + WS_QA); const bf16_t* KA = (const bf16_t*)(wsl(P) + WS_KA); const bf16_t* VA = (const bf16_t*)(wsl(P) + WS_VA);
    const float* KMEAN = (const float*)(wsl(P) + WS_KMEAN);
    const size_t rowbase = (size_t)b * SEQL + (size_t)n * 256;
    LAS float* KM = (LAS float*)(lds + ALDS_KM); LAS int* SEL = (LAS int*)(lds + ALDS_SEL);
    __syncthreads();
    for (int i = tid; i < n * 64; i += NTHR) KM[i] = KMEAN[(size_t)(b * 32 + (i >> 6)) * 512 + h * 64 + (i & 63)];
    __syncthreads();
    if (tid < 256) {
        int mask = 0;
        if (n <= 3) mask = (1 << n) - 1;
        else {
            float q[64];
            const u32x4* qp = (const u32x4*)(QA + (rowbase + tid) * 512 + h * 64);
#pragma unroll
            for (int i = 0; i < 8; ++i) { const u32x4 t = qp[i]; q[8 * i] = bflo(t.x); q[8 * i + 1] = bfhi(t.x); q[8 * i + 2] = bflo(t.y); q[8 * i + 3] = bfhi(t.y); q[8 * i + 4] = bflo(t.z); q[8 * i + 5] = bfhi(t.z); q[8 * i + 6] = bflo(t.w); q[8 * i + 7] = bfhi(t.w); }
            float v1 = -3.0e38f, v2 = -3.0e38f, v3 = -3.0e38f; int i1 = 0, i2 = 0, i3 = 0;
            for (int j = 0; j < n; ++j) {
                float g0 = 0.f, g1 = 0.f, g2 = 0.f, g3 = 0.f;
#pragma unroll
                for (int d = 0; d < 64; d += 4) { const f32x4 kmv = *(const LAS f32x4*)(KM + j * 64 + d); g0 += q[d] * kmv[0]; g1 += q[d + 1] * kmv[1]; g2 += q[d + 2] * kmv[2]; g3 += q[d + 3] * kmv[3]; }
                const float g = (g0 + g1) + (g2 + g3);
                if (g > v1) { v3 = v2; i3 = i2; v2 = v1; i2 = i1; v1 = g; i1 = j; }
                else if (g > v2) { v3 = v2; i3 = i2; v2 = g; i2 = j; }
                else if (g > v3) { v3 = g; i3 = j; }
            }
            mask = (1 << i1) | (1 << i2) | (1 << i3);
        }
        SEL[tid] = mask;
    }
    __syncthreads();
    const int sel = SEL[w * 32 + r32];
    bf16x8 qf[4];
    { const bf16_t* qrow = QA + (rowbase + w * 32 + r32) * 512 + h * 64;
#pragma unroll
      for (int ks = 0; ks < 4; ++ks) qf[ks] = *(const bf16x8*)(qrow + ks * 16 + hi * 8); }
    float m = NEGF, l = 0.f; f32x16 o0, o1;
#pragma unroll
    for (int r = 0; r < 16; ++r) { o0[r] = 0.f; o1[r] = 0.f; }
    const bf16_t* Kb = KA + (size_t)b * SEQL * 512 + h * 64; const bf16_t* Vb = VA + (size_t)b * SEQL * 512 + h * 64;
    KvRegs R;
    kv_load256(R, Kb, Vb, 512, tid);
    for (int j = 0; j <= n; ++j) {
        __syncthreads();
        kv_store256(lds, R, tid);
        __syncthreads();
        if (j < n) kv_load256(R, Kb + (size_t)(j + 1) * 256 * 512, Vb + (size_t)(j + 1) * 256 * 512, 512, tid);
        if (j < n) {
            const bool mine = (sel >> j) & 1;
            if (__any(mine)) {
                for (int t = 0; t < 8; ++t)
                    attn_tile<2>(lds + ALDS_K + t * 32 * KS_PITCH, lds + ALDS_V + t * VT_TILE, qf, m, l, o0, o1, r32, hi, mine, [&](int) { return true; });
            }
        } else {
            for (int t = 0; t < w; ++t)
                attn_tile<0>(lds + ALDS_K + t * 32 * KS_PITCH, lds + ALDS_V + t * VT_TILE, qf, m, l, o0, o1, r32, hi, true, [&](int) { return true; });
            attn_tile<1>(lds + ALDS_K + w * 32 * KS_PITCH, lds + ALDS_V + w * VT_TILE, qf, m, l, o0, o1, r32, hi, true, [&](int kc) { return kc <= r32; });
        }
    }
    float lt; { const auto rr_ = __builtin_amdgcn_permlane32_swap(__float_as_uint(l), __float_as_uint(l), false, false); lt = __uint_as_float(rr_[0]) + __uint_as_float(rr_[1]); }
    if (!dry || lt == 12345.678f) attn_store(QA + (rowbase + w * 32 + r32) * 512 + h * 64, 512, o0, o1, 1.0f / lt, hi);
}

__device__ __forceinline__ void swa_item(LAS unsigned char* lds, const Params& P, int layer, int b, int qh, int blk, bool dry = false) {
    const int tid = tid_l(), lane = tid & 63, r32 = lane & 31, hi = lane >> 5; const int w = __builtin_amdgcn_readfirstlane(tid >> 6);
    bf16_t* QC = (bf16_t*)(wsl(P) + WS_QC); const bf16_t* KC = (const bf16_t*)(wsl(P) + WS_MISC); const bf16_t* VC = KC + 128;
    const int Q0 = blk * 256, kvh = qh >> 2;
    const size_t rowq = (size_t)b * SEQL + Q0 + w * 32 + r32;
    bf16x8 qf[4];
    { const bf16_t* qrow = QC + rowq * 512 + qh * 64;
#pragma unroll
      for (int ks = 0; ks < 4; ++ks) qf[ks] = *(const bf16x8*)(qrow + ks * 16 + hi * 8); }
    __syncthreads();
    const long kbase = (long)b * SEQL + Q0 - 128;
    stage_kv(lds, KC + kbase * 512 + kvh * 64, VC + kbase * 512 + kvh * 64, 512, 384, blk == 0 ? 128 : 0, tid);
    __syncthreads();
    float m = NEGF, l = 0.f; f32x16 o0, o1;
#pragma unroll
    for (int r = 0; r < 16; ++r) { o0[r] = 0.f; o1[r] = 0.f; }
    for (int tt = w; tt <= w + 4; ++tt) {
        if (blk == 0 && tt < 4) continue;
        if (tt == w) attn_tile<1>(lds + ALDS_K + tt * 32 * KS_PITCH, lds + ALDS_V + tt * VT_TILE, qf, m, l, o0, o1, r32, hi, true, [&](int kc) { return kc > r32; });
        else if (tt == w + 4) attn_tile<1>(lds + ALDS_K + tt * 32 * KS_PITCH, lds + ALDS_V + tt * VT_TILE, qf, m, l, o0, o1, r32, hi, true, [&](int kc) { return kc <= r32; });
        else attn_tile<0>(lds + ALDS_K + tt * 32 * KS_PITCH, lds + ALDS_V + tt * VT_TILE, qf, m, l, o0, o1, r32, hi, true, [&](int) { return true; });
    }
    const float sk = P.sinks[layer * 8 + qh] * LOG2E;
    const float mn = fmaxf(m, sk); const float alpha = __builtin_amdgcn_exp2f(m - mn);
    float lsum; { const auto rr_ = __builtin_amdgcn_permlane32_swap(__float_as_uint(l), __float_as_uint(l), false, false); lsum = __uint_as_float(rr_[0]) + __uint_as_float(rr_[1]); }
    const float lt = lsum * alpha + __builtin_amdgcn_exp2f(sk - mn);
    if (!dry || lt == 12345.678f) attn_store(QC + rowq * 512 + qh * 64, 512, o0, o1, alpha / lt, hi);
}

constexpr int MP = 72;
__device__ __forceinline__ f32x4 mm_tile(const LAS bf16_t* X, const LAS bf16_t* Y, int ti, int tj, int m, int g, f32x4 acc) {
#pragma unroll
    for (int ks = 0; ks < 2; ++ks) {
        const bf16x8 a = *(const LAS bf16x8*)(X + (16 * ti + m) * MP + ks * 32 + g * 8);
        const bf16x8 b = *(const LAS bf16x8*)(Y + (16 * tj + m) * MP + ks * 32 + g * 8);
        acc = __builtin_amdgcn_mfma_f32_16x16x32_bf16(a, b, acc, 0, 0, 0);
    }
    return acc;
}
struct PreRaw { u32x4 rc, kc, vc, lc0, lc1, rp, kp, vp, lp0, lp1; };
__device__ __forceinline__ void prepass_load(PreRaw& R, const Params& P, int T, int h, int tid) {
    unsigned char* ws = wsl(P);
    const bf16_t* RB = (const bf16_t*)(ws + WS_RB); const bf16_t* KB = (const bf16_t*)(ws + WS_KB); const bf16_t* VB = (const bf16_t*)(ws + WS_VB);
    const bf16_t* LORA = (const bf16_t*)(ws + WS_MISC) + 256; const bf16_t* BND = (const bf16_t*)(ws + WS_BND);
    const int tok = tid >> 3, c8 = tid & 7; const unsigned row = (unsigned)(T * 64 + tok); const int ch = h * 64 + c8 * 8;
    R.rc = *(const u32x4*)(RB + row * 512u + ch); R.kc = *(const u32x4*)(KB + row * 512u + ch); R.vc = *(const u32x4*)(VB + row * 512u + ch);
    R.lc0 = *(const u32x4*)(LORA + row * 512u + c8 * 16); R.lc1 = *(const u32x4*)(LORA + row * 512u + c8 * 16 + 8);
    const u32x4 z = {0u, 0u, 0u, 0u}; R.rp = z; R.kp = z; R.vp = z; R.lp0 = z; R.lp1 = z;
    if ((row & (SEQL - 1)) != 0) {
        if (tok == 0) { const bf16_t* bp = BND + (unsigned)(T - 1) * 1664u;
            R.rp = *(const u32x4*)(bp + ch); R.kp = *(const u32x4*)(bp + 512 + ch); R.vp = *(const u32x4*)(bp + 1024 + ch); R.lp0 = *(const u32x4*)(bp + 1536 + c8 * 16); R.lp1 = *(const u32x4*)(bp + 1536 + c8 * 16 + 8); }
        else { R.rp = *(const u32x4*)(RB + (row - 1) * 512u + ch); R.kp = *(const u32x4*)(KB + (row - 1) * 512u + ch); R.vp = *(const u32x4*)(VB + (row - 1) * 512u + ch);
            R.lp0 = *(const u32x4*)(LORA + (row - 1) * 512u + c8 * 16); R.lp1 = *(const u32x4*)(LORA + (row - 1) * 512u + c8 * 16 + 8); }
    }
}
__device__ __forceinline__ void rwkv_prepass_head(LAS unsigned char* lds, const Params& P, int layer, int h, int T0, int Tstep, int Tend) {
    const int tid = tid_l(), tok = tid >> 3, c8 = tid & 7;
    unsigned char* ws = wsl(P);
    bf16_t* RB = (bf16_t*)(ws + WS_RB); bf16_t* KB = (bf16_t*)(ws + WS_KB); bf16_t* VB = (bf16_t*)(ws + WS_VB);
    bf16_t* DW = (bf16_t*)(ws + WS_DW); bf16_t* KK = (bf16_t*)(ws + WS_KK); bf16_t* BB = (bf16_t*)(ws + WS_BB); float* RK = (float*)(ws + WS_RK);
    const float* mu = P.mu + layer * 2176;
    LAS bf16_t* Lw = (LAS bf16_t*)lds;
    LAS bf16_t* La = (LAS bf16_t*)(lds + 9216);
    LAS bf16_t* WUt = (LAS bf16_t*)(lds + 18432);
    LAS bf16_t* AUt = (LAS bf16_t*)(lds + 27648);
    LAS float* OW = (LAS float*)(lds + 36864);
    LAS float* OA = (LAS float*)(lds + 54272);
    LAS float* PRM = (LAS float*)(lds + 71680);
    const int lane_ = tid & 63, wv_ = tid >> 6, m16 = lane_ & 15, g4 = lane_ >> 4;
    const int ch = h * 64 + c8 * 8;
    if (T0 >= Tend) return;
    __syncthreads();
    for (int i = tid; i < 4096; i += NTHR) { const int j = i >> 6, cc = i & 63; const size_t so = (size_t)layer * 64 * 512 + (size_t)j * 512 + h * 64 + cc;
        WUt[cc * MP + j] = (bf16_t)(pk2(P.w_up[so], 0.f) & 0xffffu); AUt[cc * MP + j] = (bf16_t)(pk2(P.a_up[so], 0.f) & 0xffffu); }
    if (tid < 64) { const int cc = h * 64 + tid;
        PRM[0 * 64 + tid] = P.w0[layer * 512 + cc]; PRM[1 * 64 + tid] = P.a0[layer * 512 + cc]; PRM[2 * 64 + tid] = P.k_k[layer * 512 + cc]; PRM[3 * 64 + tid] = P.k_a[layer * 512 + cc];
        PRM[4 * 64 + tid] = P.r_k[layer * 512 + cc]; PRM[5 * 64 + tid] = mu[cc]; PRM[6 * 64 + tid] = mu[512 + cc]; PRM[7 * 64 + tid] = mu[1024 + cc]; }
    if (tid >= 64 && tid < 192) PRM[512 + tid - 64] = mu[1536 + tid - 64];
    PreRaw R; prepass_load(R, P, T0, h, tid);
    for (int T = T0; T < Tend; T += Tstep) {
        const unsigned row = (unsigned)(T * 64 + tok);
        __syncthreads();
        {
            const unsigned cw[8] = {R.lc0.x, R.lc0.y, R.lc0.z, R.lc0.w, R.lc1.x, R.lc1.y, R.lc1.z, R.lc1.w}; const unsigned pw[8] = {R.lp0.x, R.lp0.y, R.lp0.z, R.lp0.w, R.lp1.x, R.lp1.y, R.lp1.z, R.lp1.w};
            unsigned pkd[8];
#pragma unroll
            for (int i = 0; i < 8; ++i) {
                const int col = c8 * 16 + 2 * i;
                const float m0 = PRM[512 + col], m1 = PRM[512 + col + 1];
                float a = bflo(cw[i]), bq = bfhi(cw[i]); a = a + (bflo(pw[i]) - a) * m0; bq = bq + (bfhi(pw[i]) - bq) * m1;
                if (col < 64) { a = 1.0f - 2.0f * __builtin_amdgcn_rcpf(1.0f + __expf(2.0f * a)); bq = 1.0f - 2.0f * __builtin_amdgcn_rcpf(1.0f + __expf(2.0f * bq)); }
                pkd[i] = pk2(a, bq);
            }
            LAS bf16_t* dstl = (c8 < 4 ? Lw : La) + tok * MP + (c8 & 3) * 16;
            *(LAS u32x4*)dstl = (u32x4){pkd[0], pkd[1], pkd[2], pkd[3]}; *(LAS u32x4*)(dstl + 8) = (u32x4){pkd[4], pkd[5], pkd[6], pkd[7]};
        }
        const PreRaw C = R;
        __syncthreads();
        if (T + Tstep < Tend) prepass_load(R, P, T + Tstep, h, tid);
#pragma unroll
        for (int q = 0; q < 2; ++q) { const int id = 2 * wv_ + q, ti = id >> 2, tj = id & 3; const f32x4 z4 = {0.f, 0.f, 0.f, 0.f};
            const f32x4 dw_ = mm_tile(Lw, WUt, ti, tj, m16, g4, z4), da_ = mm_tile(La, AUt, ti, tj, m16, g4, z4);
#pragma unroll
            for (int e = 0; e < 4; ++e) { OW[(16 * ti + 4 * g4 + e) * 68 + 16 * tj + m16] = dw_[e]; OA[(16 * ti + 4 * g4 + e) * 68 + 16 * tj + m16] = da_[e]; } }
        __syncthreads();
        float aw[8], aa[8];
        { const f32x4 w0v = *(const LAS f32x4*)(OW + tok * 68 + c8 * 8), w1v = *(const LAS f32x4*)(OW + tok * 68 + c8 * 8 + 4), a0v = *(const LAS f32x4*)(OA + tok * 68 + c8 * 8), a1v = *(const LAS f32x4*)(OA + tok * 68 + c8 * 8 + 4);
#pragma unroll
          for (int i = 0; i < 4; ++i) { aw[i] = w0v[i]; aw[4 + i] = w1v[i]; aa[i] = a0v[i]; aa[4 + i] = a1v[i]; } }
        const unsigned rcw[4] = {C.rc.x, C.rc.y, C.rc.z, C.rc.w}, rpw[4] = {C.rp.x, C.rp.y, C.rp.z, C.rp.w}, kcw[4] = {C.kc.x, C.kc.y, C.kc.z, C.kc.w}, kpw[4] = {C.kp.x, C.kp.y, C.kp.z, C.kp.w}, vcw[4] = {C.vc.x, C.vc.y, C.vc.z, C.vc.w}, vpw[4] = {C.vp.x, C.vp.y, C.vp.z, C.vp.w};
        float rs[8], ks[8], vs[8], kkr[8], av[8], dw[8];
        float ss = 0.f;
#pragma unroll
        for (int i = 0; i < 8; ++i) {
            const int cl = c8 * 8 + i; const int wi = i >> 1; const bool hiw = i & 1;
            const float r0 = hiw ? bfhi(rcw[wi]) : bflo(rcw[wi]), r1 = hiw ? bfhi(rpw[wi]) : bflo(rpw[wi]);
            const float k0 = hiw ? bfhi(kcw[wi]) : bflo(kcw[wi]), k1 = hiw ? bfhi(kpw[wi]) : bflo(kpw[wi]);
            const float v0 = hiw ? bfhi(vcw[wi]) : bflo(vcw[wi]), v1 = hiw ? bfhi(vpw[wi]) : bflo(vpw[wi]);
            rs[i] = r0 + (r1 - r0) * PRM[5 * 64 + cl]; ks[i] = k0 + (k1 - k0) * PRM[6 * 64 + cl]; vs[i] = v0 + (v1 - v0) * PRM[7 * 64 + cl];
            const float sg = sigmoidf_(PRM[0 * 64 + cl] + aw[i]);
            dw[i] = 1.0f - __expf(-0.6065306597126334f * sg);
            av[i] = sigmoidf_(PRM[1 * 64 + cl] + aa[i]);
            kkr[i] = ks[i] * PRM[2 * 64 + cl]; ss += kkr[i] * kkr[i];
        }
        ss += __shfl_xor(ss, 1); ss += __shfl_xor(ss, 2); ss += __shfl_xor(ss, 4);
        const float inv = 1.0f / fmaxf(sqrtf(ss), 1e-12f);
        float kq[8], kkn[8], bbv[8]; float rk = 0.f;
#pragma unroll
        for (int i = 0; i < 8; ++i) { const int cl = c8 * 8 + i; kkn[i] = kkr[i] * inv; kq[i] = ks[i] * (1.0f + (av[i] - 1.0f) * PRM[3 * 64 + cl]); bbv[i] = kkn[i] * av[i]; rk += rs[i] * kq[i] * PRM[4 * 64 + cl]; }
        rk += __shfl_xor(rk, 1); rk += __shfl_xor(rk, 2); rk += __shfl_xor(rk, 4);
        if (c8 == 0) RK[row * 8u + h] = rk;
        u32x4 o; const unsigned off = row * 512u + ch;
        o.x = pk2(rs[0], rs[1]); o.y = pk2(rs[2], rs[3]); o.z = pk2(rs[4], rs[5]); o.w = pk2(rs[6], rs[7]); *(u32x4*)(RB + off) = o;
        o.x = pk2(kq[0], kq[1]); o.y = pk2(kq[2], kq[3]); o.z = pk2(kq[4], kq[5]); o.w = pk2(kq[6], kq[7]); *(u32x4*)(KB + off) = o;
        o.x = pk2(vs[0], vs[1]); o.y = pk2(vs[2], vs[3]); o.z = pk2(vs[4], vs[5]); o.w = pk2(vs[6], vs[7]); *(u32x4*)(VB + off) = o;
        o.x = pk2(dw[0], dw[1]); o.y = pk2(dw[2], dw[3]); o.z = pk2(dw[4], dw[5]); o.w = pk2(dw[6], dw[7]); *(u32x4*)(DW + off) = o;
        o.x = pk2(kkn[0], kkn[1]); o.y = pk2(kkn[2], kkn[3]); o.z = pk2(kkn[4], kkn[5]); o.w = pk2(kkn[6], kkn[7]); *(u32x4*)(KK + off) = o;
        o.x = pk2(bbv[0], bbv[1]); o.y = pk2(bbv[2], bbv[3]); o.z = pk2(bbv[4], bbv[5]); o.w = pk2(bbv[6], bbv[7]); *(u32x4*)(BB + off) = o;
    }
}

constexpr int NCH = 8, LCH = SEQL / NCH;
constexpr int SC_T = 32, SC_ARR = SC_T * 64 * 4, SC_SCAL = 6 * SC_ARR, SC_BUF = 6 * SC_ARR + 512, SC_Y = 2 * SC_BUF, SC_ROW = SC_Y + 4096;
template <int CTRL> __device__ __forceinline__ float dpp_mov(float v) { return __builtin_bit_cast(float, __builtin_amdgcn_update_dpp(0, __builtin_bit_cast(int, v), CTRL, 0xF, 0xF, true)); }
__device__ __forceinline__ float red8(float v) { v += dpp_mov<0xB1>(v); v += dpp_mov<0x4E>(v); v += dpp_mov<0x141>(v); return v; }
typedef float f32x2 __attribute__((ext_vector_type(2)));
__device__ __forceinline__ void rwkv_scan_task(LAS unsigned char* lds, const Params& P, int bh, int c, int kind  ) {
    const int tid = tid_l(), lane = tid & 63, p = lane & 7; const int w = tid >> 6; const int irow0 = (w & 3) * 16 + (lane >> 3) * 2;
    const bool cw = (w < 4);
    unsigned char* ws = wsl(P);
    const bf16_t* DWp = (const bf16_t*)(ws + WS_DW); const bf16_t* KKp = (const bf16_t*)(ws + WS_KK); const bf16_t* BBp = (const bf16_t*)(ws + WS_BB);
    const bf16_t* KBp = (const bf16_t*)(ws + WS_KB); const bf16_t* RBp = (const bf16_t*)(ws + WS_RB); const bf16_t* VBp = (const bf16_t*)(ws + WS_VB);
    bf16_t* OB = (bf16_t*)(ws + WS_OB); float* PL = (float*)(ws + WS_MISC);
    const int b = bh >> 3, h = bh & 7; const unsigned row0 = (unsigned)(b * SEQL + c * LCH); const int hc = h * 64;
    const bool use_v = (kind != 1);
    f32x2 s[2][4];
#pragma unroll
    for (int r = 0; r < 2; ++r)
#pragma unroll
        for (int i = 0; i < 4; ++i) { s[r][i].x = (kind == 1 && (8 * p + 2 * i) == irow0 + r) ? 1.f : 0.f; s[r][i].y = (kind == 1 && (8 * p + 2 * i + 1) == irow0 + r) ? 1.f : 0.f; }
    __syncthreads();
    if (kind == 2 && c > 0) {
        if (cw) {
#pragma unroll
            for (int r = 0; r < 2; ++r) { const float* L0 = PL + (size_t)((bh * NCH + 0) * 2 + 0) * 4096 + (irow0 + r) * 64 + 8 * p; const f32x4 a = *(const f32x4*)L0, d = *(const f32x4*)(L0 + 4);
              s[r][0] = (f32x2){a[0], a[1]}; s[r][1] = (f32x2){a[2], a[3]}; s[r][2] = (f32x2){d[0], d[1]}; s[r][3] = (f32x2){d[2], d[3]}; }
        }
        LAS float* rowbuf = (LAS float*)(lds + SC_ROW) + irow0 * 64;
        LAS float* Pl = (LAS float*)lds;
        for (int cc = 1; cc < c; ++cc) {
            const float* Pm = PL + (size_t)((bh * NCH + cc) * 2 + 1) * 4096; const float* Lm = PL + (size_t)((bh * NCH + cc) * 2 + 0) * 4096 + irow0 * 64 + 8 * p;
            { const f32x4 q0 = *(const f32x4*)(Pm + tid * 8), q1 = *(const f32x4*)(Pm + tid * 8 + 4); *(LAS f32x4*)(Pl + tid * 8) = q0; *(LAS f32x4*)(Pl + tid * 8 + 4) = q1; }
            if (cw) {
#pragma unroll
                for (int r = 0; r < 2; ++r) { *(LAS f32x4*)(rowbuf + r * 64 + 8 * p) = (f32x4){s[r][0].x, s[r][0].y, s[r][1].x, s[r][1].y}; *(LAS f32x4*)(rowbuf + r * 64 + 8 * p + 4) = (f32x4){s[r][2].x, s[r][2].y, s[r][3].x, s[r][3].y}; }
            }
            __syncthreads();
            if (cw) {
                f32x4 n[2][2];
#pragma unroll
                for (int r = 0; r < 2; ++r) { n[r][0] = *(const f32x4*)(Lm + r * 64); n[r][1] = *(const f32x4*)(Lm + r * 64 + 4); }
#pragma unroll 8
                for (int m = 0; m < 64; ++m) { const float s0 = rowbuf[m], s1 = rowbuf[64 + m]; const f32x4 pa = *(const LAS f32x4*)(Pl + m * 64 + 8 * p), pb = *(const LAS f32x4*)(Pl + m * 64 + 8 * p + 4);
                    n[0][0] += s0 * pa; n[0][1] += s0 * pb; n[1][0] += s1 * pa; n[1][1] += s1 * pb; }
#pragma unroll
                for (int r = 0; r < 2; ++r) { s[r][0] = (f32x2){n[r][0][0], n[r][0][1]}; s[r][1] = (f32x2){n[r][0][2], n[r][0][3]}; s[r][2] = (f32x2){n[r][1][0], n[r][1][1]}; s[r][3] = (f32x2){n[r][1][2], n[r][1][3]}; }
            }
            __syncthreads();
        }
    }
    const int pc = tid & 255, lt = pc >> 3, lc8 = pc & 7, half = tid >> 8;
    u32x4 g0, g1, g2, g3;
    auto gload = [&](int tile) {
        const unsigned off = (row0 + (unsigned)(tile * SC_T + lt)) * 512u + (unsigned)(hc + lc8 * 8);
        if (half == 0) { g0 = *(const u32x4*)(DWp + off); g1 = *(const u32x4*)(RBp + off); g2 = *(const u32x4*)(KKp + off); }
        else { g0 = *(const u32x4*)(BBp + off); g1 = *(const u32x4*)(KBp + off); g2 = *(const u32x4*)(RBp + off); g3 = *(const u32x4*)(VBp + off); }
    };
    auto unpack = [&](const u32x4& u, f32x4& a, f32x4& d) { a[0] = bflo(u.x); a[1] = bfhi(u.x); a[2] = bflo(u.y); a[3] = bfhi(u.y); d[0] = bflo(u.z); d[1] = bfhi(u.z); d[2] = bflo(u.w); d[3] = bfhi(u.w); };
    auto lstore = [&](int buf) {
        LAS unsigned char* B = lds + buf * SC_BUF; const int e = (lt * 64 + lc8 * 8) * 4;
        f32x4 a0, a1, b0, b1, c0, c1;
        unpack(g0, a0, a1); unpack(g1, b0, b1); unpack(g2, c0, c1);
        if (half == 0) {
            a0 = 1.0f - a0; a1 = 1.0f - a1;
            *(LAS f32x4*)(B + 0 * SC_ARR + e) = a0; *(LAS f32x4*)(B + 0 * SC_ARR + e + 16) = a1;
            *(LAS f32x4*)(B + 4 * SC_ARR + e) = a0 * b0; *(LAS f32x4*)(B + 4 * SC_ARR + e + 16) = a1 * b1;
            *(LAS f32x4*)(B + 1 * SC_ARR + e) = c0; *(LAS f32x4*)(B + 1 * SC_ARR + e + 16) = c1;
        } else {
            f32x4 d0, d1; unpack(g3, d0, d1);
            *(LAS f32x4*)(B + 2 * SC_ARR + e) = a0; *(LAS f32x4*)(B + 2 * SC_ARR + e + 16) = a1;
            *(LAS f32x4*)(B + 3 * SC_ARR + e) = b0; *(LAS f32x4*)(B + 3 * SC_ARR + e + 16) = b1;
            if (!use_v) { d0 = (f32x4){0.f, 0.f, 0.f, 0.f}; d1 = d0; }
            *(LAS f32x4*)(B + 5 * SC_ARR + e) = d0; *(LAS f32x4*)(B + 5 * SC_ARR + e + 16) = d1;
            const f32x4 x = a0 * c0 + a1 * c1, y = b0 * c0 + b1 * c1;
            float br = (x[0] + x[1]) + (x[2] + x[3]), kr = (y[0] + y[1]) + (y[2] + y[3]);
            br = red8(br); kr = red8(kr);
            if (lc8 == 0) { LAS float* sc = (LAS float*)(B + SC_SCAL); sc[lt * 2] = br; sc[lt * 2 + 1] = kr; }
        }
    };
    gload(0); lstore(0);
    __syncthreads();
    constexpr int NTILE = LCH / SC_T;
    for (int tile = 0; tile < NTILE; ++tile) {
        const int buf = tile & 1;
        if (tile + 1 < NTILE) gload(tile + 1);
        const LAS unsigned char* B = lds + buf * SC_BUF;
        LAS unsigned short* ytile = (LAS unsigned short*)(lds + SC_Y);
        if (cw) {
#define SC_LOAD(S, t_) do { const int e_ = ((t_) * 64 + p * 8) * 4; \
                S##w0 = *(const LAS f32x4*)(B + 0 * SC_ARR + e_); S##w1 = *(const LAS f32x4*)(B + 0 * SC_ARR + e_ + 16); \
                S##q0 = *(const LAS f32x4*)(B + 1 * SC_ARR + e_); S##q1 = *(const LAS f32x4*)(B + 1 * SC_ARR + e_ + 16); \
                S##b0 = *(const LAS f32x4*)(B + 2 * SC_ARR + e_); S##b1 = *(const LAS f32x4*)(B + 2 * SC_ARR + e_ + 16); \
                S##k0 = *(const LAS f32x4*)(B + 3 * SC_ARR + e_); S##k1 = *(const LAS f32x4*)(B + 3 * SC_ARR + e_ + 16); \
                S##x0 = *(const LAS f32x4*)(B + 4 * SC_ARR + e_); S##x1 = *(const LAS f32x4*)(B + 4 * SC_ARR + e_ + 16); \
                S##vv = *(const LAS f32x2*)(B + 5 * SC_ARR + ((t_) * 64 + irow0) * 4); S##sc = *(const LAS f32x2*)(B + SC_SCAL + (t_) * 8); } while (0)
#define SC_STEP(S, t_) do { \
                const f32x2 wv[4] = {{S##w0[0], S##w0[1]}, {S##w0[2], S##w0[3]}, {S##w1[0], S##w1[1]}, {S##w1[2], S##w1[3]}}; \
                const f32x2 qv[4] = {{S##q0[0], S##q0[1]}, {S##q0[2], S##q0[3]}, {S##q1[0], S##q1[1]}, {S##q1[2], S##q1[3]}}; \
                const f32x2 bv[4] = {{S##b0[0], S##b0[1]}, {S##b0[2], S##b0[3]}, {S##b1[0], S##b1[1]}, {S##b1[2], S##b1[3]}}; \
                const f32x2 kv[4] = {{S##k0[0], S##k0[1]}, {S##k0[2], S##k0[3]}, {S##k1[0], S##k1[1]}, {S##k1[2], S##k1[3]}}; \
                const f32x2 xv[4] = {{S##x0[0], S##x0[1]}, {S##x0[2], S##x0[3]}, {S##x1[0], S##x1[1]}, {S##x1[2], S##x1[3]}}; \
                float d1[2], d2[2]; \
                _Pragma("unroll") for (int r = 0; r < 2; ++r) { f32x2 a1 = s[r][0] * qv[0], a2 = s[r][0] * xv[0]; \
                    _Pragma("unroll") for (int i = 1; i < 4; ++i) { a1 += s[r][i] * qv[i]; a2 += s[r][i] * xv[i]; } \
                    d1[r] = a1.x + a1.y; d2[r] = a2.x + a2.y; } \
                d1[0] = red8(d1[0]); d1[1] = red8(d1[1]); d2[0] = red8(d2[0]); d2[1] = red8(d2[1]); \
                _Pragma("unroll") for (int r = 0; r < 2; ++r) { const float sa = -d1[r], v = r == 0 ? S##vv.x : S##vv.y; const f32x2 sa2 = {sa, sa}, v2 = {v, v}; \
                    _Pragma("unroll") for (int i = 0; i < 4; ++i) { f32x2 tq = sa2 * bv[i]; tq += v2 * kv[i]; s[r][i] = s[r][i] * wv[i] + tq; } \
                    if (kind == 2) { const float y = d2[r] + sa * S##sc.x + v * S##sc.y; if (p == 0) ytile[(t_) * 64 + irow0 + r] = (unsigned short)(pk2(y, 0.f) & 0xffffu); } } } while (0)
            f32x4 Aw0, Aw1, Aq0, Aq1, Ab0, Ab1, Ak0, Ak1, Ax0, Ax1; f32x2 Avv, Asc;
            f32x4 Bw0, Bw1, Bq0, Bq1, Bb0, Bb1, Bk0, Bk1, Bx0, Bx1; f32x2 Bvv, Bsc;
            SC_LOAD(A, 0);
            for (int t = 0; t < SC_T; t += 2) {
                SC_LOAD(B, t + 1);
                SC_STEP(A, t);
                if (t + 2 < SC_T) SC_LOAD(A, t + 2);
                SC_STEP(B, t + 1);
            }
#undef SC_LOAD
#undef SC_STEP
        }
        if (tile + 1 < NTILE) lstore(buf ^ 1);
        __syncthreads();
        if (kind == 2 && tid < 256) {
            const int t = tid >> 3, c8 = tid & 7;
            const u32x4 yv = *(const LAS u32x4*)(lds + SC_Y + (t * 64 + c8 * 8) * 2);
            *(u32x4*)(OB + (row0 + (unsigned)(tile * SC_T + t)) * 512u + (unsigned)(hc + c8 * 8)) = yv;
        }
        __syncthreads();
    }
    if (kind != 2 && cw) {
#pragma unroll
        for (int r = 0; r < 2; ++r) { float* dst = PL + (size_t)((bh * NCH + c) * 2 + kind) * 4096 + (irow0 + r) * 64 + 8 * p;
            *(f32x4*)dst = (f32x4){s[r][0].x, s[r][0].y, s[r][1].x, s[r][1].y}; *(f32x4*)(dst + 4) = (f32x4){s[r][2].x, s[r][2].y, s[r][3].x, s[r][3].y}; }
    }
}
__device__ __forceinline__ void rwkv_gn_row(const Params& P, int layer, size_t row, int lane) {
    bf16_t* OB = (bf16_t*)(wsl(P) + WS_OB); const bf16_t* VB = (const bf16_t*)(wsl(P) + WS_VB); const float* RK = (const float*)(wsl(P) + WS_RK);
    const int ch = lane * 8; const int h = lane >> 3;
    const u32x4 yv = *(const u32x4*)(OB + row * 512 + ch), vv = *(const u32x4*)(VB + row * 512 + ch);
    float y[8] = {bflo(yv.x), bfhi(yv.x), bflo(yv.y), bfhi(yv.y), bflo(yv.z), bfhi(yv.z), bflo(yv.w), bfhi(yv.w)};
    const float v[8] = {bflo(vv.x), bfhi(vv.x), bflo(vv.y), bfhi(vv.y), bflo(vv.z), bfhi(vv.z), bflo(vv.w), bfhi(vv.w)};
    float s = 0.f;
#pragma unroll
    for (int i = 0; i < 8; ++i) s += y[i];
    s += __shfl_xor(s, 1); s += __shfl_xor(s, 2); s += __shfl_xor(s, 4);
    const float mean = s * (1.f / 64.f); float q = 0.f;
#pragma unroll
    for (int i = 0; i < 8; ++i) { y[i] -= mean; q += y[i] * y[i]; }
    q += __shfl_xor(q, 1); q += __shfl_xor(q, 2); q += __shfl_xor(q, 4);
    const float rstd = 1.0f / sqrtf(q * (1.f / 64.f) + 64.0f * 1e-5f);
    const float rk = RK[row * 8 + h];
    const bf16_t* ZB = (const bf16_t*)(wsl(P) + WS_DW);
    const u32x4 zc = *(const u32x4*)(ZB + row * 512 + ch); u32x4 zp = {0u, 0u, 0u, 0u};
    if ((row & (SEQL - 1)) != 0) zp = *(const u32x4*)(ZB + (row - 1) * 512 + ch);
    const float z0[8] = {bflo(zc.x), bfhi(zc.x), bflo(zc.y), bfhi(zc.y), bflo(zc.z), bfhi(zc.z), bflo(zc.w), bfhi(zc.w)};
    const float z1[8] = {bflo(zp.x), bfhi(zp.x), bflo(zp.y), bfhi(zp.y), bflo(zp.z), bfhi(zp.z), bflo(zp.w), bfhi(zp.w)};
    float o[8];
    const f32x4 mu0 = *(const f32x4*)(P.mu + layer * 2176 + 1664 + ch), mu1 = *(const f32x4*)(P.mu + layer * 2176 + 1664 + ch + 4);
    const f32x4 gg0 = *(const f32x4*)(P.gn_g + layer * 512 + ch), gg1 = *(const f32x4*)(P.gn_g + layer * 512 + ch + 4), gb0 = *(const f32x4*)(P.gn_b + layer * 512 + ch), gb1 = *(const f32x4*)(P.gn_b + layer * 512 + ch + 4);
#pragma unroll
    for (int i = 0; i < 8; ++i) { const float muv = i < 4 ? mu0[i & 3] : mu1[i & 3], ggv = i < 4 ? gg0[i & 3] : gg1[i & 3], gbv = i < 4 ? gb0[i & 3] : gb1[i & 3];
        const float z = z0[i] + (z1[i] - z0[i]) * muv;
        o[i] = (y[i] * rstd * ggv + gbv + rk * v[i]) * z * sigmoidf_(z); }
    u32x4 ov; ov.x = pk2(o[0], o[1]); ov.y = pk2(o[2], o[3]); ov.z = pk2(o[4], o[5]); ov.w = pk2(o[6], o[7]);
    *(u32x4*)(OB + row * 512 + ch) = ov;
}

#define XB_TMO      128
#define XB_XCNT(j)  (256  + 64 * (j))
#define XB_XSUB(j)  (1280 + 64 * (j))
#define XB_XGEN(j)  (2304 + 64 * (j))
#define XB_TOP      3328
#define XB_TOPGEN   3392
#define XCD_BAR_WORDS 3456
#define XB_SPIN_CAP (1u << 18)

__device__ __forceinline__ unsigned xb_ld(unsigned* p)              { return __hip_atomic_load(p, __ATOMIC_RELAXED, __HIP_MEMORY_SCOPE_AGENT); }
__device__ __forceinline__ unsigned xb_add(unsigned* p, unsigned v) { return __hip_atomic_fetch_add(p, v, __ATOMIC_RELAXED, __HIP_MEMORY_SCOPE_AGENT); }
__device__ __forceinline__ unsigned xb_xcc_id() { return (unsigned)__builtin_amdgcn_s_getreg((3 << 11) | 20) & 0xFu; }
#define XB_SPIN(cond, bar) do { unsigned _sp = 0; while (cond) { __builtin_amdgcn_s_sleep(1); \
    if ((++_sp & 255u) == 0u) { if (xb_ld(&(bar)[XB_TMO])) break; if (_sp > XB_SPIN_CAP) { atomicAdd(&(bar)[XB_TMO], 1u); break; } } } } while (0)

struct XcdBarrier {
    unsigned* bar; unsigned x;
    volatile LAS unsigned* st;
};

__device__ __forceinline__ XcdBarrier xcd_barrier_post(unsigned* bar, volatile LAS unsigned* st) {
    XcdBarrier b; b.bar = bar; b.x = xb_xcc_id(); b.st = st;
    if (threadIdx.x == 0) (void)xb_add(&bar[XB_XCNT(b.x)], 1u);
    return b;
}
__device__ __forceinline__ void xcd_barrier_complete(unsigned* bar, unsigned x, unsigned& nloc, unsigned& nx) {
    const unsigned G = gridDim.x * gridDim.y * gridDim.z;
    unsigned sum, cnt, mine, sp = 0u;
    for (;;) {
        sum = 0u; cnt = 0u; mine = 0u;
#pragma unroll
        for (unsigned j = 0; j < 16; ++j) { const unsigned c = xb_ld(&bar[XB_XCNT(j)]); sum += c; cnt += (c > 0u) ? 1u : 0u; mine = (j == x) ? c : mine; }
        if (sum == G) break;
        __builtin_amdgcn_s_sleep(1);
        if ((++sp & 255u) == 0u) { if (xb_ld(&bar[XB_TMO])) break; if (sp > XB_SPIN_CAP) { atomicAdd(&bar[XB_TMO], 1u); break; } }
    }
    nloc = mine > 0u ? mine : 1u; nx = cnt > 0u ? cnt : 1u;
}

__device__ __forceinline__ void xcd_barrier(const XcdBarrier& b) {
    asm volatile("s_waitcnt vmcnt(0)" ::: "memory");
    __syncthreads();
    if (threadIdx.x == 0) {
        unsigned* bar = b.bar;
        __builtin_amdgcn_s_waitcnt(0);
        unsigned nloc = b.st[0], nx = b.st[1];
        if (nloc == 0u) { xcd_barrier_complete(bar, b.x, nloc, nx); b.st[0] = nloc; b.st[1] = nx; }
        const unsigned old = xb_add(&bar[XB_XSUB(b.x)], 1u);
        const unsigned gen = old / nloc;
        if (old + 1u == (gen + 1u) * nloc) {
            __builtin_amdgcn_fence(__ATOMIC_RELEASE, "agent");
            asm volatile("s_waitcnt vmcnt(0)" ::: "memory");
            const unsigned og = xb_add(&bar[XB_TOP], 1u);
            const unsigned tg = og / nx;
            if (og + 1u == (tg + 1u) * nx) xb_add(&bar[XB_TOPGEN], 1u);
            else XB_SPIN(xb_ld(&bar[XB_TOPGEN]) == tg, bar);
            __builtin_amdgcn_fence(__ATOMIC_ACQUIRE, "agent");
            xb_add(&bar[XB_XGEN(b.x)], 1u);
            asm volatile("s_waitcnt vmcnt(0)" ::: "memory");
        } else {
            XB_SPIN(xb_ld(&bar[XB_XGEN(b.x)]) == gen, bar);
            __builtin_amdgcn_fence(__ATOMIC_ACQUIRE, "agent");
            asm volatile("s_waitcnt vmcnt(0)" ::: "memory");
        }
    }
    __syncthreads();
}

__global__ void __launch_bounds__(NTHR, 2) hybrid_fwd(Params P) {
    extern __shared__ __attribute__((aligned(16))) unsigned char lds_raw[];
    LAS unsigned char* lds = (LAS unsigned char*)lds_raw;
    cg::grid_group grid = cg::this_grid();
    LAS int* qslot = (LAS int*)(lds + 147440);
    volatile LAS unsigned* xst = (volatile LAS unsigned*)(lds + 147424);
    if (threadIdx.x < 2) xst[threadIdx.x] = 0u;
    __syncthreads();
    const XcdBarrier xbar = xcd_barrier_post((unsigned*)(P.ws + WS_CTL) + 4096, xst);

#ifdef PROBE_A_LO
    LAS unsigned long long* tsv = (LAS unsigned long long*)(lds + 147200);
    if (blockIdx.x == 0 && threadIdx.x == 0) tsv[0] = __builtin_amdgcn_s_memrealtime();
#endif
    for (int gs = 0; gs < NLAYER * 14; ++gs) {
        const int layer = gs / 14, st = gs % 14;
        int G = gridDim.x; asm volatile("" : "+s"(G)); const int NGW = G * 8;
        const int tid = tid_l(), lane = tid & 63; const int wave = __builtin_amdgcn_readfirstlane(tid >> 6); const int gw = blockIdx.x * 8 + wave;
        unsigned char* wsb = wsl(P);
        unsigned* ctl = (unsigned*)(wsb + WS_CTL);
        bf16_t* XB = (bf16_t*)(wsb + WS_XB); bf16_t* WIN = (bf16_t*)(wsb + WS_WIN); bf16_t* WBR = (bf16_t*)(wsb + WS_WBR); bf16_t* WOUT = (bf16_t*)(wsb + WS_WOUT);
        float* cosT = (float*)(wsb + WS_COS); float* sinT = (float*)(wsb + WS_SIN); float* KMEAN = (float*)(wsb + WS_KMEAN);
        const bool is_gemm = (st == 1 || st == 5 || st >= 7);
        if (is_gemm) {
            const bf16_t* A = XB; const bf16_t* Bt = WIN; int N = 1024, K = 1024, mode = 0, br = 0;
            if (st == 1) { N = 4096; }
            else if (st == 5) { Bt = WIN + (size_t)4096 * 1024; N = 1536; mode = 1; }
            else if (st == 13) { A = (const bf16_t*)(wsl(P) + WS_MERGED); Bt = WOUT; mode = 4; }
            else { br = (st - 7) >> 1;
                if (((st - 7) & 1) == 0) { A = (const bf16_t*)(wsl(P) + (br == 0 ? WS_QA : (br == 1 ? WS_OB : WS_QC))); Bt = WBR + (size_t)br * 1024 * 512; K = 512; mode = 2; }
                else { Bt = WIN + (size_t)(5632 + br * 1024) * 1024; mode = 3; } }
            pg8::Gemm g{A, Bt, MTOK, N, K}; pg8::StaticOrder S; S.init(MTOK, N, G, (int)blockIdx.x);
            EpiAll E{Epi1{wsl(P)}, EpiZ{wsl(P)}, EpiY{(bf16_t*)(wsl(P) + WS_Y)}, EpiG{(const bf16_t*)(wsl(P) + WS_Y), (bf16_t*)(wsl(P) + WS_MERGED), br == 0 ? 1 : 0}, EpiOut{layer == 0 ? P.x : (const float*)P.out, P.out}, mode};
            pg8::gemm_phase<EpiAll, pg8::StaticOrder, true, true>(lds, g, S, E);
            __syncthreads();
#ifdef PROBE_DBL_GEMM1
            if (st == 1) { grid.sync(); pg8::gemm_phase<EpiAll, pg8::StaticOrder, true, true>(lds, g, S, E); __syncthreads(); }
#endif
#ifdef PROBE_GEMM1_NOEPI
            if (st == 1) { xcd_barrier(xbar); EpiAll E2 = E; { int m99 = 99; asm volatile("" : "+s"(m99)); E2.mode = m99; } pg8::gemm_phase<EpiAll, pg8::StaticOrder, true, true>(lds, g, S, E2); __syncthreads(); }
#endif
        } else if (st == 0) {
#ifdef PROBE_SYNC10
            for (int r = 0; r < 10; ++r) grid.sync();
#endif
#ifdef PROBE_DBL_P0
            for (int rep = 0; rep < (layer == 0 ? 2 : 1); ++rep) {
#else
            {
#endif
            LAS float* scr = (LAS float*)(lds + wave * 16384);
            constexpr int I_IN = 16 * 272, I_BR = 8 * 32, I_OUT = 16 * 32, NIT = I_IN + 3 * I_BR + I_OUT;
            for (int it = gw; it < NIT; it += NGW) {
                int r = it;
                if (r < I_IN) { const int kb = r / 272, nb = r % 272; transpose_item(P.w_in + (size_t)layer * DM * INW, INW, WIN, 1024, kb * 64, nb * 32, win_map(nb * 32 + 4 * (lane & 7)), scr, lane); continue; }
                r -= I_IN;
                if (r < 3 * I_BR) { const int br = r / I_BR, q = r % I_BR, kb = q / 32, nb = q % 32; const float* W = (br == 0 ? P.wba : br == 1 ? P.wbb : P.wbc) + (size_t)layer * 512 * 1024;
                    transpose_item(W, 1024, WBR + (size_t)br * 1024 * 512, 512, kb * 64, nb * 32, nb * 32 + 4 * (lane & 7), scr, lane); continue; }
                r -= 3 * I_BR;
                { const int kb = r / 32, nb = r % 32; transpose_item(P.w_out + (size_t)layer * 1024 * 1024, 1024, WOUT, 1024, kb * 64, nb * 32, nb * 32 + 4 * (lane & 7), scr, lane); }
            }
            for (int m = gw; m < MTOK; m += NGW) {
                if (layer == 0) row_to_bf16(P.x + (size_t)m * DM, nullptr, XB + (size_t)m * DM, nullptr, nullptr, false, lane);
                else row_to_bf16(P.out + (size_t)m * DM, P.out + (size_t)m * DM, XB + (size_t)m * DM, P.ln_g + (layer - 1) * DM, P.ln_b + (layer - 1) * DM, true, lane);
            }
            if (layer == 0) {
                for (int i = blockIdx.x * NTHR + tid; i < MTOK * 32; i += G * NTHR) { const int m = i >> 5, f = i & 31;
                    const float inv = powf(10000.0f, -(float)f / 32.0f); const float ang = (float)P.pos[m] * inv; cosT[i] = cosf(ang); sinT[i] = sinf(ang); }
            }
            for (int i = blockIdx.x * NTHR + tid; i < 64 * 512; i += G * NTHR) KMEAN[i] = 0.f;
            }
        } else if (st == 2) {
            rwkv_prepass_head(lds, P, layer, (int)blockIdx.x & 7, (int)blockIdx.x >> 3, G >> 3, MTOK / 64);
            for (int it = blockIdx.x; it < 512; it += G) { const int b = it >> 8, qh = (it >> 5) & 7, blk = it & 31; swa_item(lds, P, layer, b, qh, blk); }
        } else if (st == 3) {
#ifdef PROBE_DBL_A
            for (int rep = 0; rep < 2; ++rep)
#endif
            for (int t = blockIdx.x; t < 16 * 13; t += G) {
                if (t < 16 * 7) rwkv_scan_task(lds, P, t / 7, t % 7, 0);
                else { const int q = t - 16 * 7; rwkv_scan_task(lds, P, q / 6, 1 + q % 6, 1); }
            }
        } else if (st == 4) {
#ifdef PROBE_DBL_C
            for (int rep = 0; rep < 2; ++rep)
#endif
            for (int t = blockIdx.x; t < 16 * NCH; t += G) rwkv_scan_task(lds, P, t >> 3, t & 7, 2);
            unsigned* ctr = ctl + 64 * (2 + layer * 4);
            for (;;) {
                __syncthreads();
                if (tid == 0) *qslot = (int)atomicAdd(ctr, 1u);
                __syncthreads();
                const int it = *qslot;
                if (it >= 512) break;
                const int n = 31 - (it >> 4), bh = it & 15;
                moba_item(lds_raw, lds, P, bh >> 3, bh & 7, n);
            }
        } else {
            for (int m = gw; m < MTOK; m += NGW) rwkv_gn_row(P, layer, (size_t)m, lane);
        }
        if (!(st >= 7 && st <= 11)) { if (gs == 0) grid.sync(); else xcd_barrier(xbar); }
#ifdef PROBE_A_LO
        if (blockIdx.x == 0 && threadIdx.x == 0) tsv[gs + 1] = __builtin_amdgcn_s_memrealtime();
#endif
    }
    { const int tid = tid_l(), lane = tid & 63; const int gw = blockIdx.x * 8 + (tid >> 6); const int NGW = gridDim.x * 8;
      for (int m = gw; m < MTOK; m += NGW) row_to_bf16(P.out + (size_t)m * DM, P.out + (size_t)m * DM, nullptr, P.ln_g + DM, P.ln_b + DM, true, lane); }
#ifdef PROBE_A_LO
    {
        float* dl = (float*)(P.ws + WS_CTL + 4096);
        if (blockIdx.x == 0 && threadIdx.x == 0) { const float ta = (float)(tsv[PROBE_A_HI] - tsv[PROBE_A_LO]) * 0.01f, tb = (float)(tsv[PROBE_B_HI] - tsv[PROBE_B_LO]) * 0.01f; dl[0] = ta; dl[1] = tb * 0.01f; }
        grid.sync();
        const float ta = __hip_atomic_load(dl, __ATOMIC_RELAXED, __HIP_MEMORY_SCOPE_AGENT), db = __hip_atomic_load(dl + 1, __ATOMIC_RELAXED, __HIP_MEMORY_SCOPE_AGENT);
        for (int i = blockIdx.x * NTHR + threadIdx.x; i < (1 << 20); i += gridDim.x * NTHR) P.out[i] += db + (i == 0 ? ta : 0.f);
    }
#endif
}

extern "C" void kernel_launch(void* const* d_in, const int* in_sizes, int n_in, void* d_out, int out_size, void* d_ws, size_t ws_size, hipStream_t stream) {
    static int grid = 0;
    if (grid == 0) {
        if (n_in != 20 || ws_size < WS_END) { fprintf(stderr, "kernel_launch: unexpected inputs (n_in %d, ws %zu)\n", n_in, ws_size); grid = -1; return; }
        int dev = 0, cus = 0, per_cu = 0;
        hipGetDevice(&dev); hipDeviceGetAttribute(&cus, hipDeviceAttributeMultiprocessorCount, dev);
        hipFuncSetAttribute((const void*)hybrid_fwd, hipFuncAttributeMaxDynamicSharedMemorySize, LDS_BYTES);
        hipOccupancyMaxActiveBlocksPerMultiprocessor(&per_cu, (const void*)hybrid_fwd, NTHR, LDS_BYTES);
        if (per_cu < 1) { fprintf(stderr, "kernel_launch: occupancy query says %d blocks per CU\n", per_cu); per_cu = 1; }
        grid = cus;
    }
    if (grid < 0) return;
    hipMemsetAsync((char*)d_ws + WS_CTL, 0, 32768, stream);
    Params p{};
    p.x = (const float*)d_in[0]; p.pos = (const int*)d_in[1]; p.w_in = (const float*)d_in[2]; p.mu = (const float*)d_in[3]; p.w0 = (const float*)d_in[4]; p.w_up = (const float*)d_in[5];
    p.a0 = (const float*)d_in[6]; p.a_up = (const float*)d_in[7]; p.k_k = (const float*)d_in[8]; p.k_a = (const float*)d_in[9]; p.r_k = (const float*)d_in[10]; p.gn_g = (const float*)d_in[11];
    p.gn_b = (const float*)d_in[12]; p.sinks = (const float*)d_in[13]; p.wba = (const float*)d_in[14]; p.wbb = (const float*)d_in[15]; p.wbc = (const float*)d_in[16]; p.w_out = (const float*)d_in[17];
    p.ln_g = (const float*)d_in[18]; p.ln_b = (const float*)d_in[19]; p.out = (float*)d_out; p.ws = (unsigned char*)d_ws;
    void* args[] = {&p};
    hipError_t e = hipLaunchCooperativeKernel((const void*)hybrid_fwd, dim3(grid), dim3(NTHR), args, LDS_BYTES, stream);
    if (e != hipSuccess) fprintf(stderr, "cooperative launch failed: %s (grid %d)\n", hipGetErrorString(e), grid);
}
```
